# Optimizing an MI355X kernel written in HIP

```python
import jax, jax.numpy as jnp
from jax import lax
import numpy as np

D_MODEL = 1024
BATCH = 16
SEQ = 2048
DEPTH = 2

N_A_LAYERS = DEPTH // 2
N_B_LAYERS = DEPTH - N_A_LAYERS

CHUNK = 64
EPS = 1e-6
NEG_INF = -1e30

HEADS_A = 16
HEAD_DIM_A = D_MODEL // HEADS_A
LEFT_CHUNKS = 8
BAND = (LEFT_CHUNKS + 1) * CHUNK
MAX_REL = 128

HEADS_B = D_MODEL // 128
NOPE_DIM = 128
ROPE_DIM = 64
V_DIM = 128
Q_LORA = 768
KV_LORA = 256
ROPE_THETA = 10000.0
Q_BLOCK = 128

D_FF = ((8 * D_MODEL // 3 + 127) // 128) * 128

kernel_name = "yoco_chunked_relpos_mla_macaron"


def rms_norm(x, g):
    xf = x.astype(jnp.float32)
    y = xf * lax.rsqrt(jnp.mean(xf * xf, axis=-1, keepdims=True) + EPS)
    return (y * g.astype(jnp.float32)).astype(x.dtype)


def swiglu(h, w_in, w_out):
    u = h @ w_in
    return (jax.nn.silu(u[..., :D_FF]) * u[..., D_FF:]) @ w_out


def rope_tables(seq_len):
    half = ROPE_DIM // 2
    freqs = ROPE_THETA ** (-jnp.arange(half, dtype=jnp.float32) / half)
    ang = jnp.arange(seq_len, dtype=jnp.float32)[:, None] * freqs[None, :]
    return jnp.cos(ang), jnp.sin(ang)


def apply_rope(x, cos, sin):
    half = ROPE_DIM // 2
    cos = cos.astype(x.dtype)
    sin = sin.astype(x.dtype)
    x1, x2 = x[..., :half], x[..., half:]
    return jnp.concatenate([x1 * cos - x2 * sin, x2 * cos + x1 * sin], axis=-1)


def chunked_relpos_attention(h, w_qkv, w_o, rel_table):
    B, S, _ = h.shape
    nc = S // CHUNK
    qkv = (h @ w_qkv).reshape(B, S, 3, HEADS_A, HEAD_DIM_A)
    q, k, v = qkv[:, :, 0], qkv[:, :, 1], qkv[:, :, 2]
    pad = LEFT_CHUNKS * CHUNK
    kp = jnp.pad(k, ((0, 0), (pad, 0), (0, 0), (0, 0)))
    vp = jnp.pad(v, ((0, 0), (pad, 0), (0, 0), (0, 0)))
    qi = jnp.arange(CHUNK)[:, None]
    kj = jnp.arange(BAND)[None, :]
    rel_idx = jnp.clip(pad + qi - kj, -MAX_REL, MAX_REL) + MAX_REL
    bias = rel_table[:, rel_idx].astype(jnp.float32)
    q_chunks = jnp.moveaxis(q.reshape(B, nc, CHUNK, HEADS_A, HEAD_DIM_A), 1, 0)
    scale = HEAD_DIM_A ** -0.5

    def one_chunk(args):
        qc, c = args
        start = c * CHUNK
        kb = lax.dynamic_slice_in_dim(kp, start, BAND, axis=1)
        vb = lax.dynamic_slice_in_dim(vp, start, BAND, axis=1)
        s = jnp.einsum('bqhd,bkhd->bhqk', qc, kb).astype(jnp.float32) * scale + bias
        valid = kj >= pad - start
        s = jnp.where(valid[None, None], s, NEG_INF)
        p = jax.nn.softmax(s, axis=-1).astype(vb.dtype)
        return jnp.einsum('bhqk,bkhd->bqhd', p, vb)

    out = lax.map(one_chunk, (q_chunks, jnp.arange(nc)))
    out = jnp.moveaxis(out, 0, 1).reshape(B, S, HEADS_A * HEAD_DIM_A)
    return out @ w_o


def mla_shared_kv(h_kv, w_down, latent_norm, w_up, cos, sin):
    B, S, _ = h_kv.shape
    ckr = h_kv @ w_down
    c_kv = rms_norm(ckr[..., :KV_LORA], latent_norm)
    k_rope = apply_rope(ckr[..., KV_LORA:], cos, sin)
    kv = (c_kv @ w_up).reshape(B, S, HEADS_B, NOPE_DIM + V_DIM)
    return kv[..., :NOPE_DIM], k_rope, kv[..., NOPE_DIM:]


def mla_attention(h, w_dq, q_norm, w_uq, w_o, k_nope, k_rope, v, cos, sin):
    B, S, _ = h.shape
    cq = rms_norm(h @ w_dq, q_norm)
    q = (cq @ w_uq).reshape(B, S, HEADS_B, NOPE_DIM + ROPE_DIM)
    q_nope = q[..., :NOPE_DIM]
    q_rope = apply_rope(q[..., NOPE_DIM:], cos[:, None], sin[:, None])
    nb = S // Q_BLOCK
    qn_blocks = jnp.moveaxis(q_nope.reshape(B, nb, Q_BLOCK, HEADS_B, NOPE_DIM), 1, 0)
    qr_blocks = jnp.moveaxis(q_rope.reshape(B, nb, Q_BLOCK, HEADS_B, ROPE_DIM), 1, 0)
    key_chunk = jnp.arange(S) // CHUNK
    scale = (NOPE_DIM + ROPE_DIM) ** -0.5

    def one_block(args):
        qn, qr, bidx = args
        s = (jnp.einsum('bqhd,bkhd->bhqk', qn, k_nope)
             + jnp.einsum('bqhr,bkr->bhqk', qr, k_rope)).astype(jnp.float32) * scale
        q_chunk = (bidx * Q_BLOCK + jnp.arange(Q_BLOCK)) // CHUNK
        mask = key_chunk[None, :] <= q_chunk[:, None]
        s = jnp.where(mask[None, None], s, NEG_INF)
        p = jax.nn.softmax(s, axis=-1).astype(v.dtype)
        return jnp.einsum('bhqk,bkhd->bqhd', p, v)

    out = lax.map(one_block, (qn_blocks, qr_blocks, jnp.arange(nb)))
    out = jnp.moveaxis(out, 0, 1).reshape(B, S, HEADS_B * V_DIM)
    return out @ w_o


def setup_inputs(seed: int = 0) -> dict:
    key = jax.random.key(seed)
    ks = jax.random.split(key, 24)

    def w(k, shape, fan_in):
        return jax.random.normal(k, shape, jnp.float32) * fan_in ** -0.5

    def gain(k, shape):
        return 1.0 + 0.05 * jax.random.normal(k, shape, jnp.float32)

    return {
        "x": jax.random.normal(ks[0], (BATCH, SEQ, D_MODEL), jnp.float32),
        "ffn1_norm": gain(ks[1], (DEPTH, D_MODEL)),
        "ffn1_w_in": w(ks[2], (DEPTH, D_MODEL, 2 * D_FF), D_MODEL),
        "ffn1_w_out": w(ks[3], (DEPTH, D_FF, D_MODEL), D_FF),
        "mix_norm": gain(ks[4], (DEPTH, D_MODEL)),
        "ffn2_norm": gain(ks[5], (DEPTH, D_MODEL)),
        "ffn2_w_in": w(ks[6], (DEPTH, D_MODEL, 2 * D_FF), D_MODEL),
        "ffn2_w_out": w(ks[7], (DEPTH, D_FF, D_MODEL), D_FF),
        "a_w_qkv": w(ks[8], (N_A_LAYERS, D_MODEL, 3 * HEADS_A * HEAD_DIM_A), D_MODEL),
        "a_rel_bias": 0.5 * jax.random.normal(ks[9], (N_A_LAYERS, HEADS_A, 2 * MAX_REL + 1), jnp.float32),
        "a_w_o": w(ks[10], (N_A_LAYERS, HEADS_A * HEAD_DIM_A, D_MODEL), HEADS_A * HEAD_DIM_A),
        "kv_norm": gain(ks[11], (D_MODEL,)),
        "kv_w_down": w(ks[12], (D_MODEL, KV_LORA + ROPE_DIM), D_MODEL),
        "kv_latent_norm": gain(ks[13], (KV_LORA,)),
        "kv_w_up": w(ks[14], (KV_LORA, HEADS_B * (NOPE_DIM + V_DIM)), KV_LORA),
        "b_w_dq": w(ks[15], (N_B_LAYERS, D_MODEL, Q_LORA), D_MODEL),
        "b_q_norm": gain(ks[16], (N_B_LAYERS, Q_LORA)),
        "b_w_uq": w(ks[17], (N_B_LAYERS, Q_LORA, HEADS_B * (NOPE_DIM + ROPE_DIM)), Q_LORA),
        "b_w_o": w(ks[18], (N_B_LAYERS, HEADS_B * V_DIM, D_MODEL), HEADS_B * V_DIM),
        "final_norm": gain(ks[19], (D_MODEL,)),
    }


def reference(x, ffn1_norm, ffn1_w_in, ffn1_w_out, mix_norm, ffn2_norm, ffn2_w_in,
              ffn2_w_out, a_w_qkv, a_rel_bias, a_w_o, kv_norm, kv_w_down,
              kv_latent_norm, kv_w_up, b_w_dq, b_q_norm, b_w_uq, b_w_o, final_norm):
    S = x.shape[1]
    cos, sin = rope_tables(S)
    h = x
    k_nope = k_rope = v_shared = None
    for layer in range(DEPTH):
        h = h + 0.5 * swiglu(rms_norm(h, ffn1_norm[layer]), ffn1_w_in[layer], ffn1_w_out[layer])
        hn = rms_norm(h, mix_norm[layer])
        if layer < N_A_LAYERS:
            h = h + chunked_relpos_attention(hn, a_w_qkv[layer], a_w_o[layer], a_rel_bias[layer])
        else:
            li = layer - N_A_LAYERS
            h = h + mla_attention(hn, b_w_dq[li], b_q_norm[li], b_w_uq[li], b_w_o[li],
                                  k_nope, k_rope, v_shared, cos, sin)
        h = h + 0.5 * swiglu(rms_norm(h, ffn2_norm[layer]), ffn2_w_in[layer], ffn2_w_out[layer])
        if layer == N_A_LAYERS - 1:
            k_nope, k_rope, v_shared = mla_shared_kv(rms_norm(h, kv_norm), kv_w_down,
                                                     kv_latent_norm, kv_w_up, cos, sin)
    return rms_norm(h, final_norm)
```

```cpp
#include <hip/hip_runtime.h>
namespace pg8 {
#define PG8_LAS __attribute__((address_space(3)))
typedef unsigned short bf16_t;
typedef short bf16x8 __attribute__((ext_vector_type(8)));
typedef float f32x4 __attribute__((ext_vector_type(4)));
typedef unsigned u32x4 __attribute__((ext_vector_type(4)));
constexpr int BM = 256, BK = 64, HALF = 128, HTB = HALF * BK * 2  , STAGE_BYTES = 8 * HTB, NXCD = 8, WGM = 8;

__host__ __device__ __forceinline__ int lds_byte(int r, int c) { const int st = (r >> 4) * 2 + (c >> 5), rr = r & 15, cc = c & 31, ob = rr * 64 + cc * 2; return st * 1024 + (ob ^ (((ob >> 9) & 1) << 5)); }
__host__ __device__ __forceinline__ void stage_rc(int b, int& R, int& C) { const int st = b / 1024, sb = b % 1024, swz = sb ^ (((sb >> 9) & 1) << 5); R = (st >> 1) * 16 + swz / 64; C = (st & 1) * 32 + (swz % 64) / 2; }
__host__ __device__ __forceinline__ int perm32(int rho) { const int n = rho >> 4, i = rho & 15; return 8 * (i >> 2) + 4 * n + (i & 3); }

struct Unit { int pm, pn; };
struct Gemm { const bf16_t* A; const bf16_t* Bt; int M, N, K; };

struct StaticOrder {
    int nM, nN, nwg, G, c;
    __host__ __device__ void init(int M, int N, int G_, int c_) { nM = M / BM; nN = N / BM; nwg = nM * nN; G = G_; c = c_; }
    __host__ __device__ bool next(int i, Unit& u) const {
        const long L = (long)i * G + c; if (L >= nwg) return false;
        int wgid = (int)L; { const int q = nwg / NXCD, r = nwg % NXCD, xcd = wgid % NXCD, off = wgid / NXCD; wgid = (xcd < r ? xcd * (q + 1) : r * (q + 1) + (xcd - r) * q) + off; }
        const int nig = WGM * nN, gid = wgid / nig, fm = gid * WGM, gsz = (nM - fm) < WGM ? (nM - fm) : WGM;
        u.pm = fm + ((wgid % nig) % gsz); u.pn = (wgid % nig) / gsz; return true;
    }
    __device__ __forceinline__ void a_ready(const Unit&) const {}
    __device__ __forceinline__ void done(const Unit&) const {}
};


__device__ __forceinline__ unsigned cvt_pk_bf16(float lo, float hi) {
    typedef float f2_t __attribute__((ext_vector_type(2))); typedef __bf16 b2_t __attribute__((ext_vector_type(2)));
    f2_t v = {lo, hi}; b2_t b = __builtin_convertvector(v, b2_t); return __builtin_bit_cast(unsigned, b);
}
__device__ __forceinline__ u32x4 pack8(const f32x4 a, const f32x4 b) { u32x4 w; w.x = cvt_pk_bf16(a[0], a[1]); w.y = cvt_pk_bf16(a[2], a[3]); w.z = cvt_pk_bf16(b[0], b[1]); w.w = cvt_pk_bf16(b[2], b[3]); return w; }
__device__ __forceinline__ float sq4(const f32x4 a) { return (a[0] * a[0] + a[1] * a[1]) + (a[2] * a[2] + a[3] * a[3]); }
__device__ __forceinline__ float silu_mul(float g, float u) { return g * __builtin_amdgcn_rcpf(1.0f + __builtin_amdgcn_exp2f(-1.4426950408889634f * g)) * u; }

__device__ __forceinline__ f32x4 swiglu4(const f32x4 g, const f32x4 u, float rs) {
    const f32x4 t = g * (rs * -1.4426950408889634f); f32x4 e;
#pragma unroll
    for (int i = 0; i < 4; ++i) e[i] = __builtin_amdgcn_exp2f(t[i]);
    e = e + 1.0f; f32x4 r;
#pragma unroll
    for (int i = 0; i < 4; ++i) r[i] = __builtin_amdgcn_rcpf(e[i]);
    return (g * u) * (r * (rs * rs));
}
enum { EM_SWIGLU = 0, EM_RES = 1, EM_QKV = 2, EM_KVDOWN = 3, EM_KVUP = 4, EM_DQ = 5, EM_UQ = 6, EM_RES_X = 7, EM_RES_F = 8 };
constexpr float RMS_EPS = 1e-6f;
template <int MODE> struct Epi {
    static constexpr bool PERM = true, AFTER_DRAIN = false;
    const float* ssq_in; float inv_n;
    bf16_t* o0; bf16_t* o1; bf16_t* o2;
    const float* hold; float* hnew;
    float* ssq_out;
    float scale;
    const float* rope;
    __device__ __forceinline__ void operator()(const f32x4 (&acc)[2][2][4][2], const Unit& u, int wr, int wc, int fr, int fq) const {
        const int cb = wc * 32 + 8 * fq;
        if (MODE == EM_RES || MODE == EM_RES_X || MODE == EM_RES_F) {
            if (MODE == EM_RES_X) {
#pragma unroll
                for (int ai = 0; ai < 2; ++ai) {
                    f32x4 pre[4][2][2];
#pragma unroll
                    for (int m = 0; m < 4; ++m)
#pragma unroll
                        for (int bj = 0; bj < 2; ++bj) { const size_t off = (size_t)(u.pm * BM + ai * HALF + wr * 64 + m * 16 + fr) * 1024 + u.pn * BM + bj * HALF + cb;
                            pre[m][bj][0] = *(const f32x4*)(hold + off); pre[m][bj][1] = *(const f32x4*)(hold + off + 4); }
#pragma unroll
                    for (int m = 0; m < 4; ++m) { const int row = u.pm * BM + ai * HALF + wr * 64 + m * 16 + fr; float s = 0.f;
#pragma unroll
                        for (int bj = 0; bj < 2; ++bj) { const size_t off = (size_t)row * 1024 + u.pn * BM + bj * HALF + cb;
                            const f32x4 n0 = pre[m][bj][0] + acc[ai][bj][m][0] * scale, n1 = pre[m][bj][1] + acc[ai][bj][m][1] * scale;
                            *(u32x4*)(o0 + off) = pack8(n0, n1); s += sq4(n0) + sq4(n1); }
                        s += __shfl_xor(s, 16); s += __shfl_xor(s, 32);
                        if (fq == 0) unsafeAtomicAdd(ssq_out + row, s); }
                }
                return;
            }
            u32x4 prw[2][4][2];
#pragma unroll
            for (int ai = 0; ai < 2; ++ai)
#pragma unroll
                for (int m = 0; m < 4; ++m)
#pragma unroll
                    for (int bj = 0; bj < 2; ++bj) prw[ai][m][bj] = *(const u32x4*)(o0 + (size_t)(u.pm * BM + ai * HALF + wr * 64 + m * 16 + fr) * 1024 + u.pn * BM + bj * HALF + cb);
#pragma unroll
            for (int ai = 0; ai < 2; ++ai)
#pragma unroll
                for (int m = 0; m < 4; ++m) { const int row = u.pm * BM + ai * HALF + wr * 64 + m * 16 + fr; float s = 0.f;
#pragma unroll
                    for (int bj = 0; bj < 2; ++bj) { const size_t off = (size_t)row * 1024 + u.pn * BM + bj * HALF + cb; const u32x4 w = prw[ai][m][bj];
                        const f32x4 p0 = (f32x4){__builtin_bit_cast(float, w.x << 16), __builtin_bit_cast(float, w.x & 0xffff0000u), __builtin_bit_cast(float, w.y << 16), __builtin_bit_cast(float, w.y & 0xffff0000u)};
                        const f32x4 p1 = (f32x4){__builtin_bit_cast(float, w.z << 16), __builtin_bit_cast(float, w.z & 0xffff0000u), __builtin_bit_cast(float, w.w << 16), __builtin_bit_cast(float, w.w & 0xffff0000u)};
                        const f32x4 n0 = p0 + acc[ai][bj][m][0] * scale, n1 = p1 + acc[ai][bj][m][1] * scale;
                        if (MODE == EM_RES_F) { *(f32x4*)(hnew + off) = n0; *(f32x4*)(hnew + off + 4) = n1; }
                        else *(u32x4*)(o0 + off) = pack8(n0, n1);
                        s += sq4(n0) + sq4(n1); }
                    s += __shfl_xor(s, 16); s += __shfl_xor(s, 32);
                    if (fq == 0) unsafeAtomicAdd(ssq_out + row, s); }
            return;
        }
#pragma unroll
        for (int ai = 0; ai < 2; ++ai)
#pragma unroll
            for (int m = 0; m < 4; ++m) {
                const int row = u.pm * BM + ai * HALF + wr * 64 + m * 16 + fr;
                float rs = 1.f;
                rs = __builtin_amdgcn_rsqf(ssq_in[row] * inv_n + RMS_EPS);
                if (MODE == EM_SWIGLU) {
                    f32x4 a0, a1;
#pragma unroll
                    for (int e = 0; e < 1; ++e) { a0 = swiglu4(acc[ai][0][m][0], acc[ai][1][m][0], rs); a1 = swiglu4(acc[ai][0][m][1], acc[ai][1][m][1], rs); }
                    *(u32x4*)(o0 + (size_t)row * 2816 + u.pn * 128 + cb) = pack8(a0, a1);
                } else if (MODE == EM_QKV) {
                    const int t = u.pn >> 2; bf16_t* base = o0 + (size_t)t * ((size_t)32768 * 1024); const float sc = (t == 0) ? rs * scale : rs;
#pragma unroll
                    for (int bj = 0; bj < 2; ++bj)
                        *(u32x4*)(base + (size_t)row * 1024 + (u.pn & 3) * BM + bj * HALF + cb) = pack8(acc[ai][bj][m][0] * sc, acc[ai][bj][m][1] * sc);
                } else if (MODE == EM_KVDOWN) {
                    if (u.pn == 0) {
                        float s = 0.f;
#pragma unroll
                        for (int bj = 0; bj < 2; ++bj) { const f32x4 v0 = acc[ai][bj][m][0] * rs, v1 = acc[ai][bj][m][1] * rs; s += sq4(v0) + sq4(v1);
                            *(u32x4*)(o0 + (size_t)row * 256 + bj * HALF + cb) = pack8(v0, v1); }
                        s += __shfl_xor(s, 16); s += __shfl_xor(s, 32);
                        if (fq == 0) unsafeAtomicAdd(ssq_out + row, s);
                    } else if (wc == 0) {
                        const int pos = row & 2047; const float* rp = rope + ((size_t)pos * 32 + 8 * fq) * 2;
                        f32x4 y0a, y0b, y1a, y1b;
#pragma unroll
                        for (int e = 0; e < 4; ++e) {
                            { const float x1 = rs * acc[ai][0][m][0][e], x2 = rs * acc[ai][1][m][0][e], c = rp[2 * e], sn = rp[2 * e + 1]; y0a[e] = x1 * c - x2 * sn; y1a[e] = x2 * c + x1 * sn; }
                            { const float x1 = rs * acc[ai][0][m][1][e], x2 = rs * acc[ai][1][m][1][e], c = rp[8 + 2 * e], sn = rp[8 + 2 * e + 1]; y0b[e] = x1 * c - x2 * sn; y1b[e] = x2 * c + x1 * sn; }
                        }
                        *(u32x4*)(o1 + (size_t)row * 64 + 8 * fq) = pack8(y0a, y0b);
                        *(u32x4*)(o1 + (size_t)row * 64 + 32 + 8 * fq) = pack8(y1a, y1b);
                    }
                } else if (MODE == EM_KVUP) {
                    *(u32x4*)(o0 + (size_t)row * 1024 + u.pn * 128 + cb) = pack8(acc[ai][0][m][0] * rs, acc[ai][0][m][1] * rs);
                    *(u32x4*)(o1 + (size_t)row * 1024 + u.pn * 128 + cb) = pack8(acc[ai][1][m][0] * rs, acc[ai][1][m][1] * rs);
                } else if (MODE == EM_DQ) {
                    float s = 0.f;
#pragma unroll
                    for (int bj = 0; bj < 2; ++bj) { const f32x4 v0 = acc[ai][bj][m][0] * rs, v1 = acc[ai][bj][m][1] * rs; s += sq4(v0) + sq4(v1);
                        *(u32x4*)(o0 + (size_t)row * 768 + u.pn * BM + bj * HALF + cb) = pack8(v0, v1); }
                    s += __shfl_xor(s, 16); s += __shfl_xor(s, 32);
                    if (fq == 0) unsafeAtomicAdd(ssq_out + row, s);
                } else if (MODE == EM_UQ) {
                    const float sc = rs * scale;
                    if (u.pn < 4) {
#pragma unroll
                        for (int bj = 0; bj < 2; ++bj)
                            *(u32x4*)(o0 + (size_t)row * 1024 + u.pn * BM + bj * HALF + cb) = pack8(acc[ai][bj][m][0] * sc, acc[ai][bj][m][1] * sc);
                    } else {
                        const int head = (u.pn - 4) * 4 + wc; const int pos = row & 2047; const float* rp = rope + ((size_t)pos * 32 + 8 * fq) * 2;
                        f32x4 y0a, y0b, y1a, y1b;
#pragma unroll
                        for (int e = 0; e < 4; ++e) {
                            { const float x1 = sc * acc[ai][0][m][0][e], x2 = sc * acc[ai][1][m][0][e], c = rp[2 * e], sn = rp[2 * e + 1]; y0a[e] = x1 * c - x2 * sn; y1a[e] = x2 * c + x1 * sn; }
                            { const float x1 = sc * acc[ai][0][m][1][e], x2 = sc * acc[ai][1][m][1][e], c = rp[8 + 2 * e], sn = rp[8 + 2 * e + 1]; y0b[e] = x1 * c - x2 * sn; y1b[e] = x2 * c + x1 * sn; }
                        }
                        *(u32x4*)(o1 + (size_t)row * 512 + head * 64 + 8 * fq) = pack8(y0a, y0b);
                        *(u32x4*)(o1 + (size_t)row * 512 + head * 64 + 32 + 8 * fq) = pack8(y1a, y1b);
                    }
                }
            }
    }
};

template <class Epi, class Sched, bool ALIGN_EPI = false, bool SP2 = false>
__device__ __forceinline__ void gemm_phase(PG8_LAS unsigned char* lds, const Gemm g, const Sched& S, const Epi& E) {
    int tid_ = threadIdx.x; asm volatile("" : "+v"(tid_));
    const int tid = tid_, wid = __builtin_amdgcn_readfirstlane(tid >> 6), lane = tid & 63, wr = wid >> 2, wc = wid & 3, fr = lane & 15, fq = lane >> 4;
    const int K = g.K, nt = K / BK;
    unsigned voffA[2], voffB[2];
#pragma unroll
    for (int i = 0; i < 2; ++i) { int R, C; stage_rc(tid * 16 + i * 8192, R, C); const int Rb = Epi::PERM ? ((R & ~31) + perm32(R & 31)) : R;
        voffA[i] = (unsigned)(R * K + C) * 2u; voffB[i] = (unsigned)(Rb * K + C) * 2u; }
    const size_t kstep = (size_t)(BK * 2);
    const size_t hstep = (size_t)HALF * K * 2;
    const size_t tstep = 2 * hstep;
    const unsigned ldsw = (unsigned)wid * 1024u;
    const int aoff = lds_byte(wr * 64 + fr, fq * 8), boff = lds_byte(wc * 32 + fr, fq * 8);
#define PG8_SA(b, h) (((b) * 2 + (h)) * HTB)
#define PG8_SB(b, h) ((4 + (b) * 2 + (h)) * HTB)
#define PG8_STAGE(bufoff, gbase, voff) do { _Pragma("unroll") for (int _i = 0; _i < 2; ++_i) \
        __builtin_amdgcn_global_load_lds((const unsigned*)((const char*)(gbase) + (voff)[_i]), (PG8_LAS unsigned*)(lds + (bufoff) + ldsw + _i * 8192), 16, 0, 0); } while (0)
#define PG8_LDA(dst, b, h) do { _Pragma("unroll") for (int m = 0; m < 4; ++m) _Pragma("unroll") for (int k = 0; k < 2; ++k) dst[m][k] = *(const PG8_LAS bf16x8*)(lds + PG8_SA(b, h) + aoff + m * 2048 + k * 1024); } while (0)
#define PG8_LDB(dst, b, h) do { _Pragma("unroll") for (int n = 0; n < 2; ++n) _Pragma("unroll") for (int k = 0; k < 2; ++k) dst[n][k] = *(const PG8_LAS bf16x8*)(lds + PG8_SB(b, h) + boff + n * 2048 + k * 1024); } while (0)
#define PG8_MMA(ai, bj, At, Bt) do { __builtin_amdgcn_s_setprio(1); _Pragma("unroll") for (int m = 0; m < 4; ++m) _Pragma("unroll") for (int n = 0; n < 2; ++n) _Pragma("unroll") for (int k = 0; k < 2; ++k) \
        acc[ai][bj][m][n] = __builtin_amdgcn_mfma_f32_16x16x32_bf16(Bt[n][k], At[m][k], acc[ai][bj][m][n], 0, 0, 0); __builtin_amdgcn_s_setprio(0); } while (0)
#define PG8_WAIT_V(n) asm volatile("s_waitcnt vmcnt(" #n ")" ::: "memory")
#define PG8_WAIT_L(n) asm volatile("s_waitcnt lgkmcnt(" #n ")" ::: "memory")
#define PG8_BAR __builtin_amdgcn_s_barrier()
#define PG8_SCHED __builtin_amdgcn_sched_barrier(0)
    Unit cur, nxt; int ui = 0;
    if (!S.next(0, cur)) return;
    f32x4 acc[2][2][4][2];
#pragma unroll
    for (int a = 0; a < 2; ++a)
#pragma unroll
        for (int b = 0; b < 2; ++b)
#pragma unroll
            for (int m = 0; m < 4; ++m)
#pragma unroll
                for (int n = 0; n < 2; ++n) acc[a][b][m][n] = (f32x4){0.f, 0.f, 0.f, 0.f};
    bf16x8 At[4][2], B0[2][2], B1[2][2];
    const char* cA = (const char*)g.A + (size_t)cur.pm * tstep; const char* cB = (const char*)g.Bt + (size_t)cur.pn * tstep;
    S.a_ready(cur);
    if constexpr (SP2) {
        PG8_STAGE(PG8_SB(0, 0), cB, voffB); PG8_STAGE(PG8_SB(0, 1), cB + hstep, voffB); PG8_STAGE(PG8_SA(0, 0), cA, voffA); PG8_STAGE(PG8_SA(0, 1), cA + hstep, voffA);
        if (wr == 1) PG8_BAR;
        PG8_WAIT_V(2); PG8_BAR;
        PG8_STAGE(PG8_SB(1, 0), cB + kstep, voffB); PG8_STAGE(PG8_SA(1, 0), cA + kstep, voffA); PG8_STAGE(PG8_SB(1, 1), cB + hstep + kstep, voffB);
        PG8_WAIT_V(6); PG8_BAR;
    } else {
        PG8_STAGE(PG8_SB(0, 0), cB, voffB); PG8_STAGE(PG8_SA(0, 0), cA, voffA); PG8_STAGE(PG8_SB(0, 1), cB + hstep, voffB); PG8_STAGE(PG8_SA(0, 1), cA + hstep, voffA);
        if (wr == 1) PG8_BAR;
        PG8_WAIT_V(4); PG8_BAR;
        PG8_STAGE(PG8_SB(1, 0), cB + kstep, voffB); PG8_STAGE(PG8_SA(1, 0), cA + kstep, voffA); PG8_STAGE(PG8_SB(1, 1), cB + hstep + kstep, voffB);
        PG8_WAIT_V(6); PG8_BAR;
    }
    for (;;) {
        const bool has_next = S.next(ui + 1, nxt);
        const char* nA = has_next ? (const char*)g.A + (size_t)nxt.pm * tstep : cA; const char* nB = has_next ? (const char*)g.Bt + (size_t)nxt.pn * tstep : cB;
        for (int t = 0; t < nt; t += 2) {
            const bool last = (t == nt - 2);
            const char* a1 = cA + (size_t)(t + 1) * kstep;
            const char* a2 = last ? nA : cA + (size_t)(t + 2) * kstep; const char* b2 = last ? nB : cB + (size_t)(t + 2) * kstep;
            const char* a3 = a2 + kstep; const char* b3 = b2 + kstep;
            if (last && has_next) S.a_ready(nxt);
            if constexpr (SP2) {
            PG8_LDB(B0, 0, 0); PG8_LDB(B1, 0, 1); PG8_SCHED; PG8_LDA(At, 0, 0); PG8_STAGE(PG8_SA(1, 1), a1 + hstep, voffA);
            PG8_WAIT_V(8); PG8_WAIT_L(0); PG8_BAR; PG8_MMA(0, 0, At, B0); PG8_MMA(0, 1, At, B1); PG8_BAR; PG8_SCHED;
            PG8_LDA(At, 0, 1); PG8_STAGE(PG8_SB(0, 0), b2, voffB); PG8_STAGE(PG8_SB(0, 1), b2 + hstep, voffB); PG8_STAGE(PG8_SA(0, 0), a2, voffA);
            PG8_WAIT_V(8); PG8_WAIT_L(0); PG8_BAR; PG8_MMA(1, 0, At, B0); PG8_MMA(1, 1, At, B1); PG8_BAR; PG8_SCHED;
            PG8_LDB(B0, 1, 0); PG8_LDB(B1, 1, 1); PG8_SCHED; PG8_LDA(At, 1, 0); PG8_STAGE(PG8_SA(0, 1), a2 + hstep, voffA);
            PG8_WAIT_V(8); PG8_WAIT_L(0); PG8_BAR; PG8_MMA(0, 0, At, B0); PG8_MMA(0, 1, At, B1); PG8_BAR; PG8_SCHED;
            PG8_LDA(At, 1, 1); PG8_STAGE(PG8_SB(1, 0), b3, voffB); PG8_STAGE(PG8_SB(1, 1), b3 + hstep, voffB); PG8_STAGE(PG8_SA(1, 0), a3, voffA);
            PG8_WAIT_V(8); PG8_WAIT_L(0); PG8_BAR; PG8_MMA(1, 0, At, B0); PG8_MMA(1, 1, At, B1); PG8_BAR; PG8_SCHED;
            } else {
            PG8_LDB(B0, 0, 0); PG8_SCHED; PG8_LDA(At, 0, 0); PG8_STAGE(PG8_SA(1, 1), a1 + hstep, voffA);
            PG8_WAIT_L(8); PG8_BAR; PG8_WAIT_L(0); PG8_MMA(0, 0, At, B0); PG8_BAR; PG8_SCHED;
            PG8_LDB(B1, 0, 1); PG8_STAGE(PG8_SB(0, 0), b2, voffB);
            PG8_BAR; PG8_WAIT_L(0); PG8_MMA(0, 1, At, B1); PG8_BAR;
            PG8_LDA(At, 0, 1); PG8_STAGE(PG8_SA(0, 0), a2, voffA);
            PG8_BAR; PG8_WAIT_L(0); PG8_MMA(1, 0, At, B0); PG8_BAR; PG8_SCHED;
            PG8_STAGE(PG8_SB(0, 1), b2 + hstep, voffB);
            PG8_WAIT_V(6); PG8_BAR; PG8_MMA(1, 1, At, B1); PG8_BAR;
            PG8_LDB(B0, 1, 0); PG8_SCHED; PG8_LDA(At, 1, 0); PG8_STAGE(PG8_SA(0, 1), a2 + hstep, voffA);
            PG8_WAIT_L(8); PG8_BAR; PG8_WAIT_L(0); PG8_MMA(0, 0, At, B0); PG8_BAR; PG8_SCHED;
            PG8_LDB(B1, 1, 1); PG8_STAGE(PG8_SB(1, 0), b3, voffB);
            PG8_BAR; PG8_WAIT_L(0); PG8_MMA(0, 1, At, B1); PG8_BAR;
            PG8_LDA(At, 1, 1); PG8_STAGE(PG8_SA(1, 0), a3, voffA);
            PG8_BAR; PG8_WAIT_L(0); PG8_MMA(1, 0, At, B0); PG8_BAR; PG8_SCHED;
            PG8_STAGE(PG8_SB(1, 1), b3 + hstep, voffB);
            PG8_WAIT_V(6); PG8_BAR; PG8_MMA(1, 1, At, B1); PG8_BAR;
            }
        }
        if constexpr (ALIGN_EPI) { if (wr == 0) PG8_BAR; }
        if constexpr (!Epi::AFTER_DRAIN) { E(acc, cur, wr, wc, fr, fq); S.done(cur); }
        if (!has_next) break;
#pragma unroll
        for (int a = 0; a < 2; ++a)
#pragma unroll
            for (int b = 0; b < 2; ++b)
#pragma unroll
                for (int m = 0; m < 4; ++m)
#pragma unroll
                    for (int n = 0; n < 2; ++n) acc[a][b][m][n] = (f32x4){0.f, 0.f, 0.f, 0.f};
        cur = nxt; cA = nA; cB = nB; ++ui;
        if constexpr (ALIGN_EPI) { if (wr == 1) PG8_BAR; }
    }
    PG8_WAIT_V(0);
    if constexpr (!ALIGN_EPI) { if (wr == 0) PG8_BAR; }
    PG8_BAR;
    if constexpr (Epi::AFTER_DRAIN) { E.fused(acc, cur, wr, wc, fr, fq, lds, wid, lane); S.done(cur); }
#undef PG8_SA
#undef PG8_SB
#undef PG8_STAGE
#undef PG8_LDA
#undef PG8_LDB
#undef PG8_MMA
#undef PG8_WAIT_V
#undef PG8_WAIT_L
#undef PG8_BAR
#undef PG8_SCHED
}
}

#include <hip/hip_cooperative_groups.h>
#include <cstdio>
#include <cstdint>
namespace cg = cooperative_groups;
#define LAS __attribute__((address_space(3)))
typedef unsigned short bf16;
typedef float f32x4 __attribute__((ext_vector_type(4)));
typedef float f32x16 __attribute__((ext_vector_type(16)));
typedef short bf16x8 __attribute__((ext_vector_type(8)));
typedef unsigned u32x4 __attribute__((ext_vector_type(4)));
typedef unsigned u32x2 __attribute__((ext_vector_type(2)));
typedef short s16x4 __attribute__((ext_vector_type(4)));

constexpr int NWAVES = 8, NTHREADS = 512;
constexpr int BATCH = 16, SEQ = 2048, D = 1024, M = BATCH * SEQ, FF = 2816;
constexpr int LDS_BYTES = 131072 + 256, MISC_OFF = 131072;
constexpr size_t MiB = 1u << 20;
constexpr size_t WS_SSQ = 0;
constexpr size_t WS_ROPE = 2 * MiB;
constexpr size_t WS_CTL = 3 * MiB, CTL_BYTES = 16384;
constexpr size_t WS_W = 4 * MiB;
constexpr size_t W_FFIN = (size_t)5632 * 1024 * 2, W_FFOUT = (size_t)1024 * 2816 * 2;
constexpr size_t WO_FFIN0 = 0, WO_FFOUT0 = WO_FFIN0 + 4 * W_FFIN;
constexpr size_t WO_QKV = WO_FFOUT0 + 4 * W_FFOUT, WO_AWO = WO_QKV + (size_t)3072 * 1024 * 2, WO_KVD = WO_AWO + (size_t)1024 * 1024 * 2;
constexpr size_t WO_KVU = WO_KVD + (size_t)512 * 1024 * 2, WO_DQ = WO_KVU + (size_t)2048 * 256 * 2, WO_UQ = WO_DQ + (size_t)768 * 1024 * 2;
constexpr size_t WO_BWO = WO_UQ + (size_t)1536 * 768 * 2, WO_END = WO_BWO + (size_t)1024 * 1024 * 2;
static_assert(WO_END <= 96 * MiB, "weights fit");
constexpr size_t WS_HB = 100 * MiB;
constexpr size_t WS_BIG = 164 * MiB;
constexpr size_t WS_ACT = WS_BIG, WS_Q = WS_BIG, WS_K = WS_BIG + 64 * MiB, WS_V = WS_BIG + 128 * MiB;
constexpr size_t WS_QN = WS_BIG, WS_QR = WS_BIG + 64 * MiB, WS_CQ = WS_BIG + 96 * MiB;
constexpr size_t WS_KN = 356 * MiB, WS_VB = WS_KN + 64 * MiB, WS_CKV = WS_VB + 64 * MiB, WS_KR = WS_CKV + 16 * MiB, WS_END = WS_KR + 4 * MiB;
static_assert(WS_END <= 512 * MiB, "ws map");

__device__ __forceinline__ unsigned f2bf(float f) { unsigned u = __builtin_bit_cast(unsigned, f); return (u + 0x7fffu + ((u >> 16) & 1u)) >> 16; }
__device__ __forceinline__ unsigned pk2(float lo, float hi) { return f2bf(lo) | (f2bf(hi) << 16); }
__device__ __forceinline__ float wave_sum(float v) {
#pragma unroll
    for (int o = 1; o < 64; o <<= 1) v += __shfl_xor(v, o);
    return v;
}

enum { MAP_ID = 0, MAP_SWIGLU = 1, MAP_KVDOWN = 2, MAP_UQ = 3 };
template <int MAP> __device__ __forceinline__ int map_col(int np) {
    if (MAP == MAP_ID) return np;
    if (MAP == MAP_SWIGLU) { const int t = np >> 8, rem = np & 255, half = rem >> 7, c = rem & 127; return half * 2816 + 128 * t + c; }
    if (MAP == MAP_KVDOWN) { if (np < 256) return np; const int rem = np - 256, half = rem >> 7, c = rem & 127; return c < 32 ? 256 + 32 * half + c : -1; }
    if (np < 1024) { const int t = np >> 8, bj = (np >> 7) & 1, c = np & 127; return (2 * t + bj) * 192 + c; }
    { const int rem = np - 1024, t = rem >> 8, half = (rem >> 7) & 1, c = rem & 127, head = t * 4 + (c >> 5); return head * 192 + 128 + 32 * half + (c & 31); }
}
template <int MAP> __device__ __forceinline__ void conv_item(const float* W, int K, int Nsrc, int NP, bf16* WT, const float* gain, int item, int lane) {
    const int nblk = NP / 128, kb0 = item / nblk, nb = item % nblk, k0 = 64 * kb0, n0 = 128 * nb;
    const int nq = lane & 31, kh = lane >> 5;
    const int s32 = map_col<MAP>(n0 + ((4 * nq) & ~31));
    const int src = s32 + ((4 * nq) & 31);
    bf16* dst = WT + (size_t)(n0 + 4 * nq) * K + k0 + 8 * kh;
    if (s32 < 0) {
#pragma unroll
        for (int kk = 0; kk < 4; ++kk)
#pragma unroll
            for (int c = 0; c < 4; ++c) *(u32x4*)(dst + (size_t)c * K + 16 * kk) = (u32x4){0u, 0u, 0u, 0u};
        return;
    }
#pragma unroll
    for (int kp = 0; kp < 2; ++kp) {
        f32x4 v[2][8]; f32x4 g0[2], g1[2];
#pragma unroll
        for (int k2 = 0; k2 < 2; ++k2) { const int kb = k0 + 16 * (2 * kp + k2) + 8 * kh;
#pragma unroll
            for (int j = 0; j < 8; ++j) v[k2][j] = __builtin_nontemporal_load((const f32x4*)(W + (size_t)(kb + j) * Nsrc + src));
            if (gain) { g0[k2] = *(const f32x4*)(gain + kb); g1[k2] = *(const f32x4*)(gain + kb + 4); } else { g0[k2] = (f32x4){1.f, 1.f, 1.f, 1.f}; g1[k2] = g0[k2]; } }
#pragma unroll
        for (int k2 = 0; k2 < 2; ++k2)
#pragma unroll
            for (int c = 0; c < 4; ++c) { u32x4 o;
                o.x = pk2(v[k2][0][c] * g0[k2][0], v[k2][1][c] * g0[k2][1]); o.y = pk2(v[k2][2][c] * g0[k2][2], v[k2][3][c] * g0[k2][3]);
                o.z = pk2(v[k2][4][c] * g1[k2][0], v[k2][5][c] * g1[k2][1]); o.w = pk2(v[k2][6][c] * g1[k2][2], v[k2][7][c] * g1[k2][3]);
                *(u32x4*)(dst + (size_t)c * K + 16 * (2 * kp + k2)) = o; }
    }
}

struct Args {
    const float* in[20]; float* out; unsigned char* ws; int ph_lo, ph_hi, use_cg, pad;
};

template <int MLA> __device__ __forceinline__ void attn_phase(LAS unsigned char* lds, int G, int cwg,
        const bf16* Q0, const bf16* Q1, const bf16* K0, const bf16* K1, const bf16* V, bf16* O, const float* rel_table) {
    constexpr int DQK = MLA ? 192 : 64, DV = MLA ? 128 : 64, NH = MLA ? 8 : 16, NKS = DQK / 16, NDB = DV / 32;
    constexpr int KROW = DQK + 8, VROW = DV + 32;
    constexpr int KCH = DQK / 8, NKC = 64 * KCH / NTHREADS;
    constexpr int NVC = 64 * (DV / 8) / NTHREADS;
    LAS bf16* Ks = (LAS bf16*)lds;
    LAS bf16* Vt = (LAS bf16*)(lds + 64 * KROW * 2);
    LAS float* Bt = (LAS float*)(lds + 64 * KROW * 2 + 64 * VROW * 2);
    int tid_ = threadIdx.x; asm volatile("" : "+v"(tid_));
    const int tid = tid_, lane = tid & 63, wid = __builtin_amdgcn_readfirstlane(tid >> 6), r32 = lane & 31, hi = lane >> 5;
    const int nunits = BATCH * NH * 8;
    const int pi = 16 * (r32 >> 4) + 8 * ((r32 >> 2) & 1) + 4 * ((r32 >> 3) & 1) + (r32 & 3);
    for (int L = cwg; L < nunits; L += G) {
        int b, h, grp;
        if (MLA) { const int pair = L / (BATCH * NH), bh = L % (BATCH * NH); b = bh / NH; h = bh % NH; grp = (0x10235467 >> (4 * pair)) & 7; }
        else { grp = L / (BATCH * NH); const int bh = L % (BATCH * NH); b = bh / NH; h = bh % NH; }
        const int tok0 = b * SEQ;
        const int cq = 4 * grp + (wid >> 1);
        const int qrow = tok0 + 256 * grp + 32 * wid + r32;
        const int kc_lo = MLA ? 0 : ((4 * grp - 8) > 0 ? (4 * grp - 8) : 0), kc_hi = 4 * grp + 3;
        bf16x8 qf[NKS];
#pragma unroll
        for (int ks = 0; ks < NKS; ++ks) {
            const bf16* src;
            if (!MLA) src = Q0 + (size_t)qrow * 1024 + h * 64 + 16 * ks + 8 * hi;
            else src = (ks < 8) ? Q0 + (size_t)qrow * 1024 + h * 128 + 16 * ks + 8 * hi : Q1 + (size_t)qrow * 512 + h * 64 + 16 * (ks - 8) + 8 * hi;
            qf[ks] = __builtin_nontemporal_load((const bf16x8*)src);
        }
        if (!MLA) { __syncthreads(); for (int i = tid; i < 257; i += NTHREADS) Bt[i] = rel_table[h * 257 + i] * 1.4426950408889634f; }
        f32x16 o[NDB];
#pragma unroll
        for (int db = 0; db < NDB; ++db)
#pragma unroll
            for (int r = 0; r < 16; ++r) o[db][r] = 0.f;
        float mrun = -1e30f, lrun = 0.f;
        u32x4 kreg[NKC], vreg[NVC];
        auto prefetch = [&](int kc) {
            const int t0 = tok0 + 64 * kc;
#pragma unroll
            for (int j = 0; j < NKC; ++j) { const int c = tid + NTHREADS * j, row = c / KCH, ch = c % KCH; const bf16* src;
                if (!MLA) src = K0 + (size_t)(t0 + row) * 1024 + h * 64 + ch * 8;
                else src = (ch < 16) ? K0 + (size_t)(t0 + row) * 1024 + h * 128 + ch * 8 : K1 + (size_t)(t0 + row) * 64 + (ch - 16) * 8;
                kreg[j] = *(const u32x4*)src; }
#pragma unroll
            for (int j = 0; j < NVC; ++j) { const int c = tid + NTHREADS * j, kv = c / (DV / 8), dch = c % (DV / 8);
                vreg[j] = *(const u32x4*)(V + (size_t)(t0 + kv) * 1024 + h * DV + dch * 8); }
        };
        prefetch(kc_lo);
        for (int kc = kc_lo; kc <= kc_hi; ++kc) {
            __syncthreads();
#pragma unroll
            for (int j = 0; j < NKC; ++j) { const int c = tid + NTHREADS * j, row = c / KCH, ch = c % KCH; *(LAS u32x4*)(Ks + row * KROW + ch * 8) = kreg[j]; }
#pragma unroll
            for (int j = 0; j < NVC; ++j) { const int c = tid + NTHREADS * j, kv = c / (DV / 8), dch = c % (DV / 8); *(LAS u32x4*)(Vt + kv * VROW + dch * 8) = vreg[j]; }
            __syncthreads();
            if (kc < kc_hi) prefetch(kc + 1);
            const bool active = MLA ? (kc <= cq) : (kc <= cq && kc >= cq - 8);
            if (active) {
                f32x16 st[2];
#pragma unroll
                for (int p = 0; p < 2; ++p)
#pragma unroll
                    for (int r = 0; r < 16; ++r) st[p][r] = 0.f;
                {
                    constexpr int NF = 2 * NKS, KLA = MLA ? 4 : 6;
                    bf16x8 kf[NF];
#define KREAD(f) kf[f] = *(const LAS bf16x8*)(Ks + (32 * ((f) & 1) + pi) * KROW + 16 * ((f) >> 1) + 8 * hi)
#pragma unroll
                    for (int f = 0; f < KLA; ++f) KREAD(f);
                    __builtin_amdgcn_sched_barrier(0);
#pragma unroll
                    for (int g = 0; g < NKS; ++g) {
                        st[0] = __builtin_amdgcn_mfma_f32_32x32x16_bf16(kf[2 * g], qf[g], st[0], 0, 0, 0);
                        st[1] = __builtin_amdgcn_mfma_f32_32x32x16_bf16(kf[2 * g + 1], qf[g], st[1], 0, 0, 0);
                        if (2 * g + KLA < NF) KREAD(2 * g + KLA);
                        if (2 * g + KLA + 1 < NF) KREAD(2 * g + KLA + 1);
                        __builtin_amdgcn_sched_barrier(0);
                    }
#undef KREAD
                }
                if (!MLA) {
                    if (cq - kc >= 3) {
                        const float cbias = Bt[256];
#pragma unroll
                        for (int p = 0; p < 2; ++p)
#pragma unroll
                            for (int r = 0; r < 16; ++r) st[p][r] += cbias;
                    } else {
                        const int base = 64 * (cq - kc) + 32 * (wid & 1) + r32 - 8 * hi + 128;
#pragma unroll
                        for (int p = 0; p < 2; ++p)
#pragma unroll
                            for (int r = 0; r < 16; ++r) { int idx = base - (32 * p + 16 * (r >> 3) + (r & 7)); idx = idx > 256 ? 256 : idx; st[p][r] += Bt[idx]; }
                    }
                }
                float mx = st[0][0];
#pragma unroll
                for (int p = 0; p < 2; ++p)
#pragma unroll
                    for (int r = 0; r < 16; ++r) mx = fmaxf(mx, st[p][r]);
                mx = fmaxf(mx, __shfl_xor(mx, 32));
                const float mnew = fmaxf(mrun, mx), alpha = __builtin_amdgcn_exp2f(mrun - mnew);
                mrun = mnew;
                float rsum = 0.f;
#pragma unroll
                for (int p = 0; p < 2; ++p)
#pragma unroll
                    for (int r = 0; r < 16; ++r) { st[p][r] = __builtin_amdgcn_exp2f(st[p][r] - mnew); rsum += st[p][r]; }
                lrun = lrun * alpha + rsum;
                if (__any(alpha != 1.0f)) {
#pragma unroll
                for (int db = 0; db < NDB; ++db)
#pragma unroll
                    for (int r = 0; r < 16; ++r) o[db][r] *= alpha;
                }
                bf16x8 pf[2][2];
#pragma unroll
                for (int p = 0; p < 2; ++p)
#pragma unroll
                    for (int s = 0; s < 2; ++s) { u32x4 w; w.x = pg8::cvt_pk_bf16(st[p][8 * s + 0], st[p][8 * s + 1]); w.y = pg8::cvt_pk_bf16(st[p][8 * s + 2], st[p][8 * s + 3]);
                        w.z = pg8::cvt_pk_bf16(st[p][8 * s + 4], st[p][8 * s + 5]); w.w = pg8::cvt_pk_bf16(st[p][8 * s + 6], st[p][8 * s + 7]); pf[p][s] = __builtin_bit_cast(bf16x8, w); }
                {
                    constexpr int NFV = 4 * NDB, VLA = MLA ? 2 : 4;
                    bf16x8 vf[NFV];
                    const LAS bf16* vbase = Vt + (8 * hi + ((lane & 15) >> 2)) * VROW + 16 * ((lane >> 4) & 1) + 4 * (lane & 3);
#define VREAD(f) do { const LAS bf16* vp_ = vbase + (32 * (((f) / NDB) >> 1) + 16 * (((f) / NDB) & 1)) * VROW + 32 * ((f) % NDB); \
                        const s16x4 vlo_ = __builtin_bit_cast(s16x4, __builtin_amdgcn_ds_read_tr16_b64_v4i16((LAS s16x4*)vp_)); \
                        const s16x4 vhi_ = __builtin_bit_cast(s16x4, __builtin_amdgcn_ds_read_tr16_b64_v4i16((LAS s16x4*)(vp_ + 4 * VROW))); \
                        vf[f] = __builtin_shufflevector(vlo_, vhi_, 0, 1, 2, 3, 4, 5, 6, 7); } while (0)
#pragma unroll
                    for (int f = 0; f < VLA; ++f) VREAD(f);
                    __builtin_amdgcn_sched_barrier(0);
#pragma unroll
                    for (int f = 0; f < NFV; ++f) {
                        o[f % NDB] = __builtin_amdgcn_mfma_f32_32x32x16_bf16(vf[f], pf[(f / NDB) >> 1][(f / NDB) & 1], o[f % NDB], 0, 0, 0);
                        if (f + VLA < NFV) VREAD(f + VLA);
                        __builtin_amdgcn_sched_barrier(0);
                    }
#undef VREAD
                }
            }
        }
        const float ltot = lrun + __shfl_xor(lrun, 32), rl = 1.0f / ltot;
        bf16* orow = O + (size_t)qrow * 1024 + h * DV;
#pragma unroll
        for (int db = 0; db < NDB; ++db)
#pragma unroll
            for (int j = 0; j < 2; ++j) {
                const unsigned ax = pg8::cvt_pk_bf16(o[db][8 * j] * rl, o[db][8 * j + 1] * rl), ay = pg8::cvt_pk_bf16(o[db][8 * j + 2] * rl, o[db][8 * j + 3] * rl);
                const unsigned bx = pg8::cvt_pk_bf16(o[db][8 * j + 4] * rl, o[db][8 * j + 5] * rl), by = pg8::cvt_pk_bf16(o[db][8 * j + 6] * rl, o[db][8 * j + 7] * rl);
                const auto sx = __builtin_amdgcn_permlane32_swap(ax, bx, false, false); const auto sy = __builtin_amdgcn_permlane32_swap(ay, by, false, false);
                u32x4 w; w.x = sx[0]; w.y = sy[0]; w.z = sx[1]; w.w = sy[1];
                *(u32x4*)(orow + 32 * db + 16 * j + 8 * hi) = w; }
        __syncthreads();
    }
}

#define RLX_AGENT __ATOMIC_RELAXED, __HIP_MEMORY_SCOPE_AGENT
#define XB_TMO      128
#define XB_XCNT(j)  (256  + 64 * (j))
#define XB_XSUB(j)  (1280 + 64 * (j))
#define XB_XGEN(j)  (2304 + 64 * (j))
#define XB_TOP      3328
#define XB_TOPGEN   3392
#define XCD_BAR_WORDS 3456
#define XB_SPIN_CAP (1u << 18)

__device__ __forceinline__ unsigned xb_ld(unsigned* p)              { return __hip_atomic_load(p, __ATOMIC_RELAXED, __HIP_MEMORY_SCOPE_AGENT); }
__device__ __forceinline__ unsigned xb_add(unsigned* p, unsigned v) { return __hip_atomic_fetch_add(p, v, __ATOMIC_RELAXED, __HIP_MEMORY_SCOPE_AGENT); }
__device__ __forceinline__ unsigned xb_xcc_id() { return (unsigned)__builtin_amdgcn_s_getreg((3 << 11) | 20) & 0xFu; }
#define XB_SPIN(cond, bar) do { unsigned _sp = 0; while (cond) { __builtin_amdgcn_s_sleep(1); \
    if ((++_sp & 255u) == 0u) { if (xb_ld(&(bar)[XB_TMO])) break; if (_sp > XB_SPIN_CAP) { atomicAdd(&(bar)[XB_TMO], 1u); break; } } } } while (0)

struct XcdBarrier {
    unsigned* bar; unsigned x;
    volatile LAS unsigned* st;
};

__device__ __forceinline__ XcdBarrier xcd_barrier_post(unsigned* bar, volatile LAS unsigned* st) {
    XcdBarrier b; b.bar = bar; b.x = xb_xcc_id(); b.st = st;
    if (threadIdx.x == 0) (void)xb_add(&bar[XB_XCNT(b.x)], 1u);
    return b;
}
__device__ __forceinline__ void xcd_barrier_complete(unsigned* bar, unsigned x, unsigned& nloc, unsigned& nx) {
    const unsigned G = gridDim.x * gridDim.y * gridDim.z;
    unsigned sum, cnt, mine, sp = 0u;
    for (;;) {
        sum = 0u; cnt = 0u; mine = 0u;
#pragma unroll
        for (unsigned j = 0; j < 16; ++j) { const unsigned c = xb_ld(&bar[XB_XCNT(j)]); sum += c; cnt += (c > 0u) ? 1u : 0u; mine = (j == x) ? c : mine; }
        if (sum == G) break;
        __builtin_amdgcn_s_sleep(1);
        if ((++sp & 255u) == 0u) { if (xb_ld(&bar[XB_TMO])) break; if (sp > XB_SPIN_CAP) { atomicAdd(&bar[XB_TMO], 1u); break; } }
    }
    nloc = mine > 0u ? mine : 1u; nx = cnt > 0u ? cnt : 1u;
}

__device__ __forceinline__ void xcd_barrier(const XcdBarrier& b) {
    asm volatile("s_waitcnt vmcnt(0)" ::: "memory");
    __syncthreads();
    if (threadIdx.x == 0) {
        unsigned* bar = b.bar;
        __builtin_amdgcn_s_waitcnt(0);
        unsigned nloc = b.st[0], nx = b.st[1];
        if (nloc == 0u) { xcd_barrier_complete(bar, b.x, nloc, nx); b.st[0] = nloc; b.st[1] = nx; }
        const unsigned old = xb_add(&bar[XB_XSUB(b.x)], 1u);
        const unsigned gen = old / nloc;
        if (old + 1u == (gen + 1u) * nloc) {
            __builtin_amdgcn_fence(__ATOMIC_RELEASE, "agent");
            asm volatile("s_waitcnt vmcnt(0)" ::: "memory");
            const unsigned og = xb_add(&bar[XB_TOP], 1u);
            const unsigned tg = og / nx;
            if (og + 1u == (tg + 1u) * nx) xb_add(&bar[XB_TOPGEN], 1u);
            else XB_SPIN(xb_ld(&bar[XB_TOPGEN]) == tg, bar);
            __builtin_amdgcn_fence(__ATOMIC_ACQUIRE, "agent");
            xb_add(&bar[XB_XGEN(b.x)], 1u);
            asm volatile("s_waitcnt vmcnt(0)" ::: "memory");
        } else {
            XB_SPIN(xb_ld(&bar[XB_XGEN(b.x)]) == gen, bar);
            __builtin_amdgcn_fence(__ATOMIC_ACQUIRE, "agent");
            asm volatile("s_waitcnt vmcnt(0)" ::: "memory");
        }
    }
    __syncthreads();
}

__device__ __forceinline__ const void* karg_ptr(int i) {
    const __attribute__((address_space(4))) char* kp = (const __attribute__((address_space(4))) char*)__builtin_amdgcn_kernarg_segment_ptr();
    asm volatile("" : "+s"(kp));
    return *(const void* const __attribute__((address_space(4)))*)(kp + 8 * i);
}
#define KARG(i) ((const float*)karg_ptr(i))
#define WSP ((unsigned char*)karg_ptr(21))
#define HRES ((float*)karg_ptr(20))
#define SSQ ((float*)(WSP + WS_SSQ))
#define ROPE ((float*)(WSP + WS_ROPE))
#define WPTR(off) ((bf16*)(WSP + WS_W + (off)))
#define BPTR(off) ((bf16*)(WSP + (off)))
template <int PASS> __device__ __forceinline__ void convert_weights(int lane, int gw, int NGW) {
        constexpr int I_FFIN = 16 * 44, I_FFOUT = 44 * 8, I_QKV = 16 * 24, I_WO = 16 * 8, I_KVD = 16 * 4, I_KVU = 4 * 16, I_DQ = 16 * 6, I_UQ = 12 * 12;
        constexpr int NITEMS = PASS == 0 ? (2 * I_FFIN + 2 * I_FFOUT + I_QKV + I_WO) : (2 * I_FFIN + 2 * I_FFOUT + I_WO + I_KVD + I_KVU + I_DQ + I_UQ);
        for (int it = gw; it < NITEMS; it += NGW) {
            int r = it;
            if (r < 2 * I_FFIN) { const int which = r / I_FFIN, layer = PASS, w = 2 * PASS + which; r -= which * I_FFIN;
                conv_item<MAP_SWIGLU>((which ? KARG(6) : KARG(2)) + (size_t)layer * 1024 * 5632, 1024, 5632, 5632, WPTR(WO_FFIN0) + (size_t)w * (W_FFIN / 2), (which ? KARG(5) : KARG(1)) + layer * 1024, r, lane); continue; }
            r -= 2 * I_FFIN;
            if (r < 2 * I_FFOUT) { const int which = r / I_FFOUT, layer = PASS, w = 2 * PASS + which; r -= which * I_FFOUT;
                conv_item<MAP_ID>((which ? KARG(7) : KARG(3)) + (size_t)layer * 2816 * 1024, 2816, 1024, 1024, WPTR(WO_FFOUT0) + (size_t)w * (W_FFOUT / 2), nullptr, r, lane); continue; }
            r -= 2 * I_FFOUT;
            if (PASS == 0) {
                if (r < I_QKV) { conv_item<MAP_ID>(KARG(8), 1024, 3072, 3072, WPTR(WO_QKV), KARG(4), r, lane); continue; } r -= I_QKV;
                conv_item<MAP_ID>(KARG(10), 1024, 1024, 1024, WPTR(WO_AWO), nullptr, r, lane);
            } else {
                if (r < I_WO) { conv_item<MAP_ID>(KARG(18), 1024, 1024, 1024, WPTR(WO_BWO), nullptr, r, lane); continue; } r -= I_WO;
                if (r < I_KVD) { conv_item<MAP_KVDOWN>(KARG(12), 1024, 320, 512, WPTR(WO_KVD), KARG(11), r, lane); continue; } r -= I_KVD;
                if (r < I_KVU) { conv_item<MAP_ID>(KARG(14), 256, 2048, 2048, WPTR(WO_KVU), KARG(13), r, lane); continue; } r -= I_KVU;
                if (r < I_DQ) { conv_item<MAP_ID>(KARG(15), 1024, 768, 768, WPTR(WO_DQ), KARG(4) + 1024, r, lane); continue; } r -= I_DQ;
                conv_item<MAP_UQ>(KARG(17), 768, 1536, 1536, WPTR(WO_UQ), KARG(16), r, lane);
            }
        }
}
__device__ __forceinline__ void prologue_phase(LAS unsigned char* lds, int tid, int lane, int wave, int G, int bx, int gw, int NGW) {
        convert_weights<0>(lane, gw, NGW);
        { const float* x = KARG(0); bf16* hb = BPTR(WS_HB); float* ssq = SSQ; float* rope = ROPE;
        for (int m = gw; m < M; m += NGW) {
            const f32x4* xr = (const f32x4*)(x + (size_t)m * D) + lane; f32x4 v[4]; float s = 0.f;
#pragma unroll
            for (int j = 0; j < 4; ++j) { v[j] = __builtin_nontemporal_load(xr + 64 * j); s += pg8::sq4(v[j]); }
            s = wave_sum(s);
            u32x2* o8 = (u32x2*)(hb + (size_t)m * D) + lane;
#pragma unroll
            for (int j = 0; j < 4; ++j) { u32x2 w; w.x = pk2(v[j][0], v[j][1]); w.y = pk2(v[j][2], v[j][3]); o8[64 * j] = w; }
            if (lane == 0) ssq[m] = s;
        }
        for (int i = bx * NTHREADS + tid; i < 8 * M; i += G * NTHREADS) ssq[M + i] = 0.f;
        for (int i = bx * NTHREADS + tid; i < 2048 * 32; i += G * NTHREADS) { const int pos = i >> 5, j = i & 31;
            const float freq = powf(10000.0f, -(float)j / 32.0f); const float ang = (float)pos * freq; rope[2 * i] = cosf(ang); rope[2 * i + 1] = sinf(ang); }
        }
        __syncthreads();
    }
#ifndef PROBE_PRO
#define PROBE_PRO
#endif
__global__ void __launch_bounds__(NTHREADS, 2) yoco_fwd(Args args) {
    extern __shared__ __attribute__((aligned(16))) unsigned char lds_raw[];
    LAS unsigned char* lds = (LAS unsigned char*)lds_raw;
    cg::grid_group grid = cg::this_grid();
    const int tid = threadIdx.x, lane = tid & 63, wave = __builtin_amdgcn_readfirstlane(tid >> 6);
    const int G = gridDim.x, bx = blockIdx.x;
    for (int u = tid; u < 64; u += NTHREADS) ((LAS unsigned*)(lds + MISC_OFF))[u] = 0u;
    __syncthreads();
    XcdBarrier bar = xcd_barrier_post((unsigned*)((unsigned char*)karg_ptr(21) + WS_CTL), (volatile LAS unsigned*)(lds + MISC_OFF));
    const int gw = bx * NWAVES + wave, NGW = G * NWAVES;
    const int lo = args.ph_lo, hi = args.ph_hi, use_cg = args.use_cg;
#define IN(k) (lo <= (k) && (k) < hi)
#define SEAM(k) do { if (IN(k) && IN((k) + 1)) { if (use_cg) grid.sync(); else xcd_barrier(bar); } } while (0)
    constexpr float C2A = 0.125f * 1.4426950408889634f;
    constexpr float C2B = 0.07216878364870322f * 1.4426950408889634f;

    if (IN(0)) { prologue_phase(lds, tid, lane, wave, G, bx, gw, NGW); PROBE_PRO }
    SEAM(0);
#define GEMM_PHASE(MODE, Aptr, Bptr, NN, KK, EPI) do { pg8::Gemm g_{Aptr, Bptr, M, NN, KK}; pg8::StaticOrder S_; S_.init(M, NN, G, bx); \
        pg8::gemm_phase<pg8::Epi<MODE>, pg8::StaticOrder, true, true>(lds, g_, S_, EPI); } while (0)
#define FFN_IN(kssq, widx) do { pg8::Epi<pg8::EM_SWIGLU> E{SSQ + (size_t)(kssq) * M, i1024, BPTR(WS_ACT), nullptr, nullptr, nullptr, nullptr, nullptr, 1.f, nullptr}; \
        GEMM_PHASE(pg8::EM_SWIGLU, BPTR(WS_HB), WPTR(WO_FFIN0 + (widx) * W_FFIN), 5632, 1024, E); } while (0)
#define FFN_OUT(MODE, HOLD, kssq, widx) do { pg8::Epi<MODE> E{nullptr, 0.f, BPTR(WS_HB), nullptr, nullptr, HOLD, HRES, SSQ + (size_t)(kssq) * M, 0.5f, nullptr}; \
        GEMM_PHASE(MODE, BPTR(WS_ACT), WPTR(WO_FFOUT0 + (widx) * W_FFOUT), 1024, 2816, E); } while (0)
#define WO_PROJ(Aoff, Woff, kssq) do { pg8::Epi<pg8::EM_RES> E{nullptr, 0.f, BPTR(WS_HB), nullptr, nullptr, nullptr, nullptr, SSQ + (size_t)(kssq) * M, 1.0f, nullptr}; \
        GEMM_PHASE(pg8::EM_RES, BPTR(Aoff), WPTR(Woff), 1024, 1024, E); } while (0)
    const float i1024 = 1.0f / 1024.0f;
    if (IN(1)) FFN_IN(0, 0);
    SEAM(1);
    if (IN(2)) FFN_OUT(pg8::EM_RES, nullptr, 1, 0);
    SEAM(2);
    if (IN(3)) { pg8::Epi<pg8::EM_QKV> E{SSQ + 1 * M, i1024, BPTR(WS_Q), nullptr, nullptr, nullptr, nullptr, nullptr, C2A, nullptr}; GEMM_PHASE(pg8::EM_QKV, BPTR(WS_HB), WPTR(WO_QKV), 3072, 1024, E); }
    SEAM(3);
    if (IN(4)) { attn_phase<0>(lds, G, bx, BPTR(WS_Q), nullptr, BPTR(WS_K), nullptr, BPTR(WS_V), BPTR(WS_Q), KARG(9)); convert_weights<1>(lane, gw, NGW); }
    SEAM(4);
    if (IN(5)) WO_PROJ(WS_Q, WO_AWO, 2);
    SEAM(5);
    if (IN(6)) FFN_IN(2, 1);
    SEAM(6);
    if (IN(7)) FFN_OUT(pg8::EM_RES, nullptr, 3, 1);
    SEAM(7);
    if (IN(8)) {
        { pg8::Epi<pg8::EM_KVDOWN> E{SSQ + 3 * M, i1024, BPTR(WS_CKV), BPTR(WS_KR), nullptr, nullptr, nullptr, SSQ + 4 * M, 1.f, ROPE}; GEMM_PHASE(pg8::EM_KVDOWN, BPTR(WS_HB), WPTR(WO_KVD), 512, 1024, E); }
        FFN_IN(3, 2);
    }
    SEAM(8);
    if (IN(9)) {
        { pg8::Epi<pg8::EM_KVUP> E{SSQ + 4 * M, 1.0f / 256.0f, BPTR(WS_KN), BPTR(WS_VB), nullptr, nullptr, nullptr, nullptr, 1.f, nullptr}; GEMM_PHASE(pg8::EM_KVUP, BPTR(WS_CKV), WPTR(WO_KVU), 2048, 256, E); }
        FFN_OUT(pg8::EM_RES, nullptr, 5, 2);
    }
    SEAM(9);
    if (IN(10)) { pg8::Epi<pg8::EM_DQ> E{SSQ + 5 * M, i1024, BPTR(WS_CQ), nullptr, nullptr, nullptr, nullptr, SSQ + 6 * M, 1.f, nullptr}; GEMM_PHASE(pg8::EM_DQ, BPTR(WS_HB), WPTR(WO_DQ), 768, 1024, E); }
    SEAM(10);
    if (IN(11)) { pg8::Epi<pg8::EM_UQ> E{SSQ + 6 * M, 1.0f / 768.0f, BPTR(WS_QN), BPTR(WS_QR), nullptr, nullptr, nullptr, nullptr, C2B, ROPE}; GEMM_PHASE(pg8::EM_UQ, BPTR(WS_CQ), WPTR(WO_UQ), 1536, 768, E); }
    SEAM(11);
    if (IN(12)) attn_phase<1>(lds, G, bx, BPTR(WS_QN), BPTR(WS_QR), BPTR(WS_KN), BPTR(WS_KR), BPTR(WS_VB), BPTR(WS_QN), nullptr);
    SEAM(12);
    if (IN(13)) WO_PROJ(WS_QN, WO_BWO, 7);
    SEAM(13);
    if (IN(14)) FFN_IN(7, 3);
    SEAM(14);
    if (IN(15)) FFN_OUT(pg8::EM_RES_F, nullptr, 8, 3);
    SEAM(15);
    if (IN(16)) {
        float* hres = HRES; const float* ssq = SSQ; const float* final_norm = KARG(19);
        for (int m = gw; m < M; m += NGW) {
            const float rs = __builtin_amdgcn_rsqf(ssq[8 * M + m] * i1024 + pg8::RMS_EPS);
            f32x4* xr = (f32x4*)(hres + (size_t)m * D) + lane; const f32x4* gr = (const f32x4*)final_norm + lane;
#pragma unroll
            for (int j = 0; j < 4; ++j) { const f32x4 v = __builtin_nontemporal_load(xr + 64 * j), g = gr[64 * j]; __builtin_nontemporal_store(v * rs * g, xr + 64 * j); }
        }
    }
#undef IN
#undef SEAM
}

#ifndef MK_MULTI
#define MK_MULTI 0
#endif
extern "C" void kernel_launch(void* const* d_in, const int* in_sizes, int n_in, void* d_out, int out_size, void* d_ws, size_t ws_size, hipStream_t stream) {
    static int grid = 0;
    if (grid == 0) {
        int dev = 0, cus = 0, per_cu = 0;
        hipGetDevice(&dev);
        hipDeviceGetAttribute(&cus, hipDeviceAttributeMultiprocessorCount, dev);
        hipFuncSetAttribute((const void*)yoco_fwd, hipFuncAttributeMaxDynamicSharedMemorySize, LDS_BYTES);
        hipOccupancyMaxActiveBlocksPerMultiprocessor(&per_cu, (const void*)yoco_fwd, NTHREADS, LDS_BYTES);
        if (per_cu < 1) per_cu = 1;
        grid = cus * 1;
        if (n_in != 20 || ws_size < WS_END) { fprintf(stderr, "kernel_launch: unexpected n_in %d / ws_size %zu (need %zu)\n", n_in, ws_size, (size_t)WS_END); }
        (void)hipGetLastError();
    }
    (void)hipMemsetAsync((char*)d_ws + WS_CTL, 0, CTL_BYTES, stream);
    Args a{};
    for (int i = 0; i < 20; ++i) a.in[i] = (const float*)d_in[i];
    a.out = (float*)d_out; a.ws = (unsigned char*)d_ws;
#if MK_MULTI
    for (int p = 0; p < 17; ++p) { a.ph_lo = p; a.ph_hi = p + 1; void* kargs[] = {&a};
        hipLaunchCooperativeKernel((const void*)yoco_fwd, dim3(grid), dim3(NTHREADS), kargs, LDS_BYTES, stream); }
#else
    a.ph_lo = 0; a.ph_hi = 17; void* kargs[] = {&a};
    hipError_t e = hipLaunchCooperativeKernel((const void*)yoco_fwd, dim3(grid), dim3(NTHREADS), kargs, LDS_BYTES, stream);
    if (e != hipSuccess) fprintf(stderr, "cooperative launch failed: %s (grid %d)\n", hipGetErrorString(e), grid);
#endif
}
```

```cpp
#include <hip/hip_runtime.h>
namespace pg8 {
#define PG8_LAS __attribute__((address_space(3)))
typedef unsigned short bf16_t;
typedef short bf16x8 __attribute__((ext_vector_type(8)));
typedef float f32x4 __attribute__((ext_vector_type(4)));
typedef unsigned u32x4 __attribute__((ext_vector_type(4)));
constexpr int BM = 256, BK = 64, HALF = 128, HTB = HALF * BK * 2  , STAGE_BYTES = 8 * HTB, NXCD = 8, WGM = 8;

__host__ __device__ __forceinline__ int lds_byte(int r, int c) { const int st = (r >> 4) * 2 + (c >> 5), rr = r & 15, cc = c & 31, ob = rr * 64 + cc * 2; return st * 1024 + (ob ^ (((ob >> 9) & 1) << 5)); }
__host__ __device__ __forceinline__ void stage_rc(int b, int& R, int& C) { const int st = b / 1024, sb = b % 1024, swz = sb ^ (((sb >> 9) & 1) << 5); R = (st >> 1) * 16 + swz / 64; C = (st & 1) * 32 + (swz % 64) / 2; }
__host__ __device__ __forceinline__ int perm32(int rho) { const int n = rho >> 4, i = rho & 15; return 8 * (i >> 2) + 4 * n + (i & 3); }

struct Unit { int pm, pn; };
struct Gemm { const bf16_t* A; const bf16_t* Bt; int M, N, K; };

struct StaticOrder {
    int nM, nN, nwg, G, c;
    __host__ __device__ void init(int M, int N, int G_, int c_) { nM = M / BM; nN = N / BM; nwg = nM * nN; G = G_; c = c_; }
    __host__ __device__ bool next(int i, Unit& u) const {
        const long L = (long)i * G + c; if (L >= nwg) return false;
        int wgid = (int)L; { const int q = nwg / NXCD, r = nwg % NXCD, xcd = wgid % NXCD, off = wgid / NXCD; wgid = (xcd < r ? xcd * (q + 1) : r * (q + 1) + (xcd - r) * q) + off; }
        const int nig = WGM * nN, gid = wgid / nig, fm = gid * WGM, gsz = (nM - fm) < WGM ? (nM - fm) : WGM;
        u.pm = fm + ((wgid % nig) % gsz); u.pn = (wgid % nig) / gsz; return true;
    }
    __device__ __forceinline__ void a_ready(const Unit&) const {}
    __device__ __forceinline__ void done(const Unit&) const {}
};


__device__ __forceinline__ unsigned cvt_pk_bf16(float lo, float hi) {
    typedef float f2_t __attribute__((ext_vector_type(2))); typedef __bf16 b2_t __attribute__((ext_vector_type(2)));
    f2_t v = {lo, hi}; b2_t b = __builtin_convertvector(v, b2_t); return __builtin_bit_cast(unsigned, b);
}
__device__ __forceinline__ u32x4 pack8(const f32x4 a, const f32x4 b) { u32x4 w; w.x = cvt_pk_bf16(a[0], a[1]); w.y = cvt_pk_bf16(a[2], a[3]); w.z = cvt_pk_bf16(b[0], b[1]); w.w = cvt_pk_bf16(b[2], b[3]); return w; }
__device__ __forceinline__ float sq4(const f32x4 a) { return (a[0] * a[0] + a[1] * a[1]) + (a[2] * a[2] + a[3] * a[3]); }
__device__ __forceinline__ float silu_mul(float g, float u) { return g * __builtin_amdgcn_rcpf(1.0f + __builtin_amdgcn_exp2f(-1.4426950408889634f * g)) * u; }

__device__ __forceinline__ f32x4 swiglu4(const f32x4 g, const f32x4 u, float rs) {
    const f32x4 t = g * (rs * -1.4426950408889634f); f32x4 e;
#pragma unroll
    for (int i = 0; i < 4; ++i) e[i] = __builtin_amdgcn_exp2f(t[i]);
    e = e + 1.0f; f32x4 r;
#pragma unroll
    for (int i = 0; i < 4; ++i) r[i] = __builtin_amdgcn_rcpf(e[i]);
    return (g * u) * (r * (rs * rs));
}
enum { EM_SWIGLU = 0, EM_RES = 1, EM_QKV = 2, EM_KVDOWN = 3, EM_KVUP = 4, EM_DQ = 5, EM_UQ = 6, EM_RES_X = 7, EM_RES_F = 8 };
constexpr float RMS_EPS = 1e-6f;
template <int MODE> struct Epi {
    static constexpr bool PERM = true, AFTER_DRAIN = false;
    const float* ssq_in; float inv_n;
    bf16_t* o0; bf16_t* o1; bf16_t* o2;
    const float* hold; float* hnew;
    float* ssq_out;
    float scale;
    const float* rope;
    __device__ __forceinline__ void operator()(const f32x4 (&acc)[2][2][4][2], const Unit& u, int wr, int wc, int fr, int fq) const {
        const int cb = wc * 32 + 8 * fq;
        if (MODE == EM_RES || MODE == EM_RES_X || MODE == EM_RES_F) {
            if (MODE == EM_RES_X) {
#pragma unroll
                for (int ai = 0; ai < 2; ++ai) {
                    f32x4 pre[4][2][2];
#pragma unroll
                    for (int m = 0; m < 4; ++m)
#pragma unroll
                        for (int bj = 0; bj < 2; ++bj) { const size_t off = (size_t)(u.pm * BM + ai * HALF + wr * 64 + m * 16 + fr) * 1024 + u.pn * BM + bj * HALF + cb;
                            pre[m][bj][0] = *(const f32x4*)(hold + off); pre[m][bj][1] = *(const f32x4*)(hold + off + 4); }
#pragma unroll
                    for (int m = 0; m < 4; ++m) { const int row = u.pm * BM + ai * HALF + wr * 64 + m * 16 + fr; float s = 0.f;
#pragma unroll
                        for (int bj = 0; bj < 2; ++bj) { const size_t off = (size_t)row * 1024 + u.pn * BM + bj * HALF + cb;
                            const f32x4 n0 = pre[m][bj][0] + acc[ai][bj][m][0] * scale, n1 = pre[m][bj][1] + acc[ai][bj][m][1] * scale;
                            *(u32x4*)(o0 + off) = pack8(n0, n1); s += sq4(n0) + sq4(n1); }
                        s += __shfl_xor(s, 16); s += __shfl_xor(s, 32);
                        if (fq == 0) unsafeAtomicAdd(ssq_out + row, s); }
                }
                return;
            }
            u32x4 prw[2][4][2];
#pragma unroll
            for (int ai = 0; ai < 2; ++ai)
#pragma unroll
                for (int m = 0; m < 4; ++m)
#pragma unroll
                    for (int bj = 0; bj < 2; ++bj) prw[ai][m][bj] = *(const u32x4*)(o0 + (size_t)(u.pm * BM + ai * HALF + wr * 64 + m * 16 + fr) * 1024 + u.pn * BM + bj * HALF + cb);
#pragma unroll
            for (int ai = 0; ai < 2; ++ai)
#pragma unroll
                for (int m = 0; m < 4; ++m) { const int row = u.pm * BM + ai * HALF + wr * 64 + m * 16 + fr; float s = 0.f;
#pragma unroll
                    for (int bj = 0; bj < 2; ++bj) { const size_t off = (size_t)row * 1024 + u.pn * BM + bj * HALF + cb; const u32x4 w = prw[ai][m][bj];
                        const f32x4 p0 = (f32x4){__builtin_bit_cast(float, w.x << 16), __builtin_bit_cast(float, w.x & 0xffff0000u), __builtin_bit_cast(float, w.y << 16), __builtin_bit_cast(float, w.y & 0xffff0000u)};
                        const f32x4 p1 = (f32x4){__builtin_bit_cast(float, w.z << 16), __builtin_bit_cast(float, w.z & 0xffff0000u), __builtin_bit_cast(float, w.w << 16), __builtin_bit_cast(float, w.w & 0xffff0000u)};
                        const f32x4 n0 = p0 + acc[ai][bj][m][0] * scale, n1 = p1 + acc[ai][bj][m][1] * scale;
                        if (MODE == EM_RES_F) { *(f32x4*)(hnew + off) = n0; *(f32x4*)(hnew + off + 4) = n1; }
                        else *(u32x4*)(o0 + off) = pack8(n0, n1);
                        s += sq4(n0) + sq4(n1); }
                    s += __shfl_xor(s, 16); s += __shfl_xor(s, 32);
                    if (fq == 0) unsafeAtomicAdd(ssq_out + row, s); }
            return;
        }
#pragma unroll
        for (int ai = 0; ai < 2; ++ai)
#pragma unroll
            for (int m = 0; m < 4; ++m) {
                const int row = u.pm * BM + ai * HALF + wr * 64 + m * 16 + fr;
                float rs = 1.f;
                rs = __builtin_amdgcn_rsqf(ssq_in[row] * inv_n + RMS_EPS);
                if (MODE == EM_SWIGLU) {
                    f32x4 a0, a1;
#pragma unroll
                    for (int e = 0; e < 1; ++e) { a0 = swiglu4(acc[ai][0][m][0], acc[ai][1][m][0], rs); a1 = swiglu4(acc[ai][0][m][1], acc[ai][1][m][1], rs); }
                    *(u32x4*)(o0 + (size_t)row * 2816 + u.pn * 128 + cb) = pack8(a0, a1);
                } else if (MODE == EM_QKV) {
                    const int t = u.pn >> 2; bf16_t* base = o0 + (size_t)t * ((size_t)32768 * 1024); const float sc = (t == 0) ? rs * scale : rs;
#pragma unroll
                    for (int bj = 0; bj < 2; ++bj)
                        *(u32x4*)(base + (size_t)row * 1024 + (u.pn & 3) * BM + bj * HALF + cb) = pack8(acc[ai][bj][m][0] * sc, acc[ai][bj][m][1] * sc);
                } else if (MODE == EM_KVDOWN) {
                    if (u.pn == 0) {
                        float s = 0.f;
#pragma unroll
                        for (int bj = 0; bj < 2; ++bj) { const f32x4 v0 = acc[ai][bj][m][0] * rs, v1 = acc[ai][bj][m][1] * rs; s += sq4(v0) + sq4(v1);
                            *(u32x4*)(o0 + (size_t)row * 256 + bj * HALF + cb) = pack8(v0, v1); }
                        s += __shfl_xor(s, 16); s += __shfl_xor(s, 32);
                        if (fq == 0) unsafeAtomicAdd(ssq_out + row, s);
                    } else if (wc == 0) {
                        const int pos = row & 2047; const float* rp = rope + ((size_t)pos * 32 + 8 * fq) * 2;
                        f32x4 y0a, y0b, y1a, y1b;
#pragma unroll
                        for (int e = 0; e < 4; ++e) {
                            { const float x1 = rs * acc[ai][0][m][0][e], x2 = rs * acc[ai][1][m][0][e], c = rp[2 * e], sn = rp[2 * e + 1]; y0a[e] = x1 * c - x2 * sn; y1a[e] = x2 * c + x1 * sn; }
                            { const float x1 = rs * acc[ai][0][m][1][e], x2 = rs * acc[ai][1][m][1][e], c = rp[8 + 2 * e], sn = rp[8 + 2 * e + 1]; y0b[e] = x1 * c - x2 * sn; y1b[e] = x2 * c + x1 * sn; }
                        }
                        *(u32x4*)(o1 + (size_t)row * 64 + 8 * fq) = pack8(y0a, y0b);
                        *(u32x4*)(o1 + (size_t)row * 64 + 32 + 8 * fq) = pack8(y1a, y1b);
                    }
                } else if (MODE == EM_KVUP) {
                    *(u32x4*)(o0 + (size_t)row * 1024 + u.pn * 128 + cb) = pack8(acc[ai][0][m][0] * rs, acc[ai][0][m][1] * rs);
                    *(u32x4*)(o1 + (size_t)row * 1024 + u.pn * 128 + cb) = pack8(acc[ai][1][m][0] * rs, acc[ai][1][m][1] * rs);
                } else if (MODE == EM_DQ) {
                    float s = 0.f;
#pragma unroll
                    for (int bj = 0; bj < 2; ++bj) { const f32x4 v0 = acc[ai][bj][m][0] * rs, v1 = acc[ai][bj][m][1] * rs; s += sq4(v0) + sq4(v1);
                        *(u32x4*)(o0 + (size_t)row * 768 + u.pn * BM + bj * HALF + cb) = pack8(v0, v1); }
                    s += __shfl_xor(s, 16); s += __shfl_xor(s, 32);
                    if (fq == 0) unsafeAtomicAdd(ssq_out + row, s);
                } else if (MODE == EM_UQ) {
                    const float sc = rs * scale;
                    if (u.pn < 4) {
#pragma unroll
                        for (int bj = 0; bj < 2; ++bj)
                            *(u32x4*)(o0 + (size_t)row * 1024 + u.pn * BM + bj * HALF + cb) = pack8(acc[ai][bj][m][0] * sc, acc[ai][bj][m][1] * sc);
                    } else {
                        const int head = (u.pn - 4) * 4 + wc; const int pos = row & 2047; const float* rp = rope + ((size_t)pos * 32 + 8 * fq) * 2;
                        f32x4 y0a, y0b, y1a, y1b;
#pragma unroll
                        for (int e = 0; e < 4; ++e) {
                            { const float x1 = sc * acc[ai][0][m][0][e], x2 = sc * acc[ai][1][m][0][e], c = rp[2 * e], sn = rp[2 * e + 1]; y0a[e] = x1 * c - x2 * sn; y1a[e] = x2 * c + x1 * sn; }
                            { const float x1 = sc * acc[ai][0][m][1][e], x2 = sc * acc[ai][1][m][1][e], c = rp[8 + 2 * e], sn = rp[8 + 2 * e + 1]; y0b[e] = x1 * c - x2 * sn; y1b[e] = x2 * c + x1 * sn; }
                        }
                        *(u32x4*)(o1 + (size_t)row * 512 + head * 64 + 8 * fq) = pack8(y0a, y0b);
                        *(u32x4*)(o1 + (size_t)row * 512 + head * 64 + 32 + 8 * fq) = pack8(y1a, y1b);
                    }
                }
            }
    }
};

template <class Epi, class Sched, bool ALIGN_EPI = false, bool SP2 = false>
__device__ __forceinline__ void gemm_phase(PG8_LAS unsigned char* lds, const Gemm g, const Sched& S, const Epi& E) {
    int tid_ = threadIdx.x; asm volatile("" : "+v"(tid_));
    const int tid = tid_, wid = __builtin_amdgcn_readfirstlane(tid >> 6), lane = tid & 63, wr = wid >> 2, wc = wid & 3, fr = lane & 15, fq = lane >> 4;
    const int K = g.K, nt = K / BK;
    unsigned voffA[2], voffB[2];
#pragma unroll
    for (int i = 0; i < 2; ++i) { int R, C; stage_rc(tid * 16 + i * 8192, R, C); const int Rb = Epi::PERM ? ((R & ~31) + perm32(R & 31)) : R;
        voffA[i] = (unsigned)(R * K + C) * 2u; voffB[i] = (unsigned)(Rb * K + C) * 2u; }
    const size_t kstep = (size_t)(BK * 2);
    const size_t hstep = (size_t)HALF * K * 2;
    const size_t tstep = 2 * hstep;
    const unsigned ldsw = (unsigned)wid * 1024u;
    const int aoff = lds_byte(wr * 64 + fr, fq * 8), boff = lds_byte(wc * 32 + fr, fq * 8);
#define PG8_SA(b, h) (((b) * 2 + (h)) * HTB)
#define PG8_SB(b, h) ((4 + (b) * 2 + (h)) * HTB)
#define PG8_STAGE(bufoff, gbase, voff) do { _Pragma("unroll") for (int _i = 0; _i < 2; ++_i) \
        __builtin_amdgcn_global_load_lds((const unsigned*)((const char*)(gbase) + (voff)[_i]), (PG8_LAS unsigned*)(lds + (bufoff) + ldsw + _i * 8192), 16, 0, 0); } while (0)
#define PG8_LDA(dst, b, h) do { _Pragma("unroll") for (int m = 0; m < 4; ++m) _Pragma("unroll") for (int k = 0; k < 2; ++k) dst[m][k] = *(const PG8_LAS bf16x8*)(lds + PG8_SA(b, h) + aoff + m * 2048 + k * 1024); } while (0)
#define PG8_LDB(dst, b, h) do { _Pragma("unroll") for (int n = 0; n < 2; ++n) _Pragma("unroll") for (int k = 0; k < 2; ++k) dst[n][k] = *(const PG8_LAS bf16x8*)(lds + PG8_SB(b, h) + boff + n * 2048 + k * 1024); } while (0)
#define PG8_MMA(ai, bj, At, Bt) do { __builtin_amdgcn_s_setprio(1); _Pragma("unroll") for (int m = 0; m < 4; ++m) _Pragma("unroll") for (int n = 0; n < 2; ++n) _Pragma("unroll") for (int k = 0; k < 2; ++k) \
        acc[ai][bj][m][n] = __builtin_amdgcn_mfma_f32_16x16x32_bf16(Bt[n][k], At[m][k], acc[ai][bj][m][n], 0, 0, 0); __builtin_amdgcn_s_setprio(0); } while (0)
#define PG8_WAIT_V(n) asm volatile("s_waitcnt vmcnt(" #n ")" ::: "memory")
#define PG8_WAIT_L(n) asm volatile("s_waitcnt lgkmcnt(" #n ")" ::: "memory")
#define PG8_BAR __builtin_amdgcn_s_barrier()
#define PG8_SCHED __builtin_amdgcn_sched_barrier(0)
    Unit cur, nxt; int ui = 0;
    if (!S.next(0, cur)) return;
    f32x4 acc[2][2][4][2];
#pragma unroll
    for (int a = 0; a < 2; ++a)
#pragma unroll
        for (int b = 0; b < 2; ++b)
#pragma unroll
            for (int m = 0; m < 4; ++m)
#pragma unroll
                for (int n = 0; n < 2; ++n) acc[a][b][m][n] = (f32x4){0.f, 0.f, 0.f, 0.f};
    bf16x8 At[4][2], B0[2][2], B1[2][2];
    const char* cA = (const char*)g.A + (size_t)cur.pm * tstep; const char* cB = (const char*)g.Bt + (size_t)cur.pn * tstep;
    S.a_ready(cur);
    if constexpr (SP2) {
        PG8_STAGE(PG8_SB(0, 0), cB, voffB); PG8_STAGE(PG8_SB(0, 1), cB + hstep, voffB); PG8_STAGE(PG8_SA(0, 0), cA, voffA); PG8_STAGE(PG8_SA(0, 1), cA + hstep, voffA);
        if (wr == 1) PG8_BAR;
        PG8_WAIT_V(2); PG8_BAR;
        PG8_STAGE(PG8_SB(1, 0), cB + kstep, voffB); PG8_STAGE(PG8_SA(1, 0), cA + kstep, voffA); PG8_STAGE(PG8_SB(1, 1), cB + hstep + kstep, voffB);
        PG8_WAIT_V(6); PG8_BAR;
    } else {
        PG8_STAGE(PG8_SB(0, 0), cB, voffB); PG8_STAGE(PG8_SA(0, 0), cA, voffA); PG8_STAGE(PG8_SB(0, 1), cB + hstep, voffB); PG8_STAGE(PG8_SA(0, 1), cA + hstep, voffA);
        if (wr == 1) PG8_BAR;
        PG8_WAIT_V(4); PG8_BAR;
        PG8_STAGE(PG8_SB(1, 0), cB + kstep, voffB); PG8_STAGE(PG8_SA(1, 0), cA + kstep, voffA); PG8_STAGE(PG8_SB(1, 1), cB + hstep + kstep, voffB);
        PG8_WAIT_V(6); PG8_BAR;
    }
    for (;;) {
        const bool has_next = S.next(ui + 1, nxt);
        const char* nA = has_next ? (const char*)g.A + (size_t)nxt.pm * tstep : cA; const char* nB = has_next ? (const char*)g.Bt + (size_t)nxt.pn * tstep : cB;
        for (int t = 0; t < nt; t += 2) {
            const bool last = (t == nt - 2);
            const char* a1 = cA + (size_t)(t + 1) * kstep;
            const char* a2 = last ? nA : cA + (size_t)(t + 2) * kstep; const char* b2 = last ? nB : cB + (size_t)(t + 2) * kstep;
            const char* a3 = a2 + kstep; const char* b3 = b2 + kstep;
            if (last && has_next) S.a_ready(nxt);
            if constexpr (SP2) {
            PG8_LDB(B0, 0, 0); PG8_LDB(B1, 0, 1); PG8_SCHED; PG8_LDA(At, 0, 0); PG8_STAGE(PG8_SA(1, 1), a1 + hstep, voffA);
            PG8_WAIT_V(8); PG8_WAIT_L(0); PG8_BAR; PG8_MMA(0, 0, At, B0); PG8_MMA(0, 1, At, B1); PG8_BAR; PG8_SCHED;
            PG8_LDA(At, 0, 1); PG8_STAGE(PG8_SB(0, 0), b2, voffB); PG8_STAGE(PG8_SB(0, 1), b2 + hstep, voffB); PG8_STAGE(PG8_SA(0, 0), a2, voffA);
            PG8_WAIT_V(8); PG8_WAIT_L(0); PG8_BAR; PG8_MMA(1, 0, At, B0); PG8_MMA(1, 1, At, B1); PG8_BAR; PG8_SCHED;
            PG8_LDB(B0, 1, 0); PG8_LDB(B1, 1, 1); PG8_SCHED; PG8_LDA(At, 1, 0); PG8_STAGE(PG8_SA(0, 1), a2 + hstep, voffA);
            PG8_WAIT_V(8); PG8_WAIT_L(0); PG8_BAR; PG8_MMA(0, 0, At, B0); PG8_MMA(0, 1, At, B1); PG8_BAR; PG8_SCHED;
            PG8_LDA(At, 1, 1); PG8_STAGE(PG8_SB(1, 0), b3, voffB); PG8_STAGE(PG8_SB(1, 1), b3 + hstep, voffB); PG8_STAGE(PG8_SA(1, 0), a3, voffA);
            PG8_WAIT_V(8); PG8_WAIT_L(0); PG8_BAR; PG8_MMA(1, 0, At, B0); PG8_MMA(1, 1, At, B1); PG8_BAR; PG8_SCHED;
            } else {
            PG8_LDB(B0, 0, 0); PG8_SCHED; PG8_LDA(At, 0, 0); PG8_STAGE(PG8_SA(1, 1), a1 + hstep, voffA);
            PG8_WAIT_L(8); PG8_BAR; PG8_WAIT_L(0); PG8_MMA(0, 0, At, B0); PG8_BAR; PG8_SCHED;
            PG8_LDB(B1, 0, 1); PG8_STAGE(PG8_SB(0, 0), b2, voffB);
            PG8_BAR; PG8_WAIT_L(0); PG8_MMA(0, 1, At, B1); PG8_BAR;
            PG8_LDA(At, 0, 1); PG8_STAGE(PG8_SA(0, 0), a2, voffA);
            PG8_BAR; PG8_WAIT_L(0); PG8_MMA(1, 0, At, B0); PG8_BAR; PG8_SCHED;
            PG8_STAGE(PG8_SB(0, 1), b2 + hstep, voffB);
            PG8_WAIT_V(6); PG8_BAR; PG8_MMA(1, 1, At, B1); PG8_BAR;
            PG8_LDB(B0, 1, 0); PG8_SCHED; PG8_LDA(At, 1, 0); PG8_STAGE(PG8_SA(0, 1), a2 + hstep, voffA);
            PG8_WAIT_L(8); PG8_BAR; PG8_WAIT_L(0); PG8_MMA(0, 0, At, B0); PG8_BAR; PG8_SCHED;
            PG8_LDB(B1, 1, 1); PG8_STAGE(PG8_SB(1, 0), b3, voffB);
            PG8_BAR; PG8_WAIT_L(0); PG8_MMA(0, 1, At, B1); PG8_BAR;
            PG8_LDA(At, 1, 1); PG8_STAGE(PG8_SA(1, 0), a3, voffA);
            PG8_BAR; PG8_WAIT_L(0); PG8_MMA(1, 0, At, B0); PG8_BAR; PG8_SCHED;
            PG8_STAGE(PG8_SB(1, 1), b3 + hstep, voffB);
            PG8_WAIT_V(6); PG8_BAR; PG8_MMA(1, 1, At, B1); PG8_BAR;
            }
        }
        if constexpr (ALIGN_EPI) { if (wr == 0) PG8_BAR; }
        if constexpr (!Epi::AFTER_DRAIN) { E(acc, cur, wr, wc, fr, fq); S.done(cur); }
        if (!has_next) break;
#pragma unroll
        for (int a = 0; a < 2; ++a)
#pragma unroll
            for (int b = 0; b < 2; ++b)
#pragma unroll
                for (int m = 0; m < 4; ++m)
#pragma unroll
                    for (int n = 0; n < 2; ++n) acc[a][b][m][n] = (f32x4){0.f, 0.f, 0.f, 0.f};
        cur = nxt; cA = nA; cB = nB; ++ui;
        if constexpr (ALIGN_EPI) { if (wr == 1) PG8_BAR; }
    }
    PG8_WAIT_V(0);
    if constexpr (!ALIGN_EPI) { if (wr == 0) PG8_BAR; }
    PG8_BAR;
    if constexpr (Epi::AFTER_DRAIN) { E.fused(acc, cur, wr, wc, fr, fq, lds, wid, lane); S.done(cur); }
#undef PG8_SA
#undef PG8_SB
#undef PG8_STAGE
#undef PG8_LDA
#undef PG8_LDB
#undef PG8_MMA
#undef PG8_WAIT_V
#undef PG8_WAIT_L
#undef PG8_BAR
#undef PG8_SCHED
}
}

#include <hip/hip_cooperative_groups.h>
#include <cstdio>
#include <cstdint>
namespace cg = cooperative_groups;
#define LAS __attribute__((address_space(3)))
typedef unsigned short bf16;
typedef float f32x4 __attribute__((ext_vector_type(4)));
typedef float f32x16 __attribute__((ext_vector_type(16)));
typedef short bf16x8 __attribute__((ext_vector_type(8)));
typedef unsigned u32x4 __attribute__((ext_vector_type(4)));
typedef unsigned u32x2 __attribute__((ext_vector_type(2)));
typedef short s16x4 __attribute__((ext_vector_type(4)));

constexpr int NWAVES = 8, NTHREADS = 512;
constexpr int BATCH = 16, SEQ = 2048, D = 1024, M = BATCH * SEQ, FF = 2816;
constexpr int LDS_BYTES = 131072 + 256, MISC_OFF = 131072;
constexpr size_t MiB = 1u << 20;
constexpr size_t WS_SSQ = 0;
constexpr size_t WS_ROPE = 2 * MiB;
constexpr size_t WS_CTL = 3 * MiB, CTL_BYTES = 16384;
constexpr size_t WS_W = 4 * MiB;
constexpr size_t W_FFIN = (size_t)5632 * 1024 * 2, W_FFOUT = (size_t)1024 * 2816 * 2;
constexpr size_t WO_FFIN0 = 0, WO_FFOUT0 = WO_FFIN0 + 4 * W_FFIN;
constexpr size_t WO_QKV = WO_FFOUT0 + 4 * W_FFOUT, WO_AWO = WO_QKV + (size_t)3072 * 1024 * 2, WO_KVD = WO_AWO + (size_t)1024 * 1024 * 2;
constexpr size_t WO_KVU = WO_KVD + (size_t)512 * 1024 * 2, WO_DQ = WO_KVU + (size_t)2048 * 256 * 2, WO_UQ = WO_DQ + (size_t)768 * 1024 * 2;
constexpr size_t WO_BWO = WO_UQ + (size_t)1536 * 768 * 2, WO_END = WO_BWO + (size_t)1024 * 1024 * 2;
static_assert(WO_END <= 96 * MiB, "weights fit");
constexpr size_t WS_HB = 100 * MiB;
constexpr size_t WS_BIG = 164 * MiB;
constexpr size_t WS_ACT = WS_BIG, WS_Q = WS_BIG, WS_K = WS_BIG + 64 * MiB, WS_V = WS_BIG + 128 * MiB;
constexpr size_t WS_QN = WS_BIG, WS_QR = WS_BIG + 64 * MiB, WS_CQ = WS_BIG + 96 * MiB;
constexpr size_t WS_KN = 356 * MiB, WS_VB = WS_KN + 64 * MiB, WS_CKV = WS_VB + 64 * MiB, WS_KR = WS_CKV + 16 * MiB, WS_END = WS_KR + 4 * MiB;
static_assert(WS_END <= 512 * MiB, "ws map");

__device__ __forceinline__ unsigned f2bf(float f) { unsigned u = __builtin_bit_cast(unsigned, f); return (u + 0x7fffu + ((u >> 16) & 1u)) >> 16; }
__device__ __forceinline__ unsigned pk2(float lo, float hi) { return f2bf(lo) | (f2bf(hi) << 16); }
__device__ __forceinline__ float wave_sum(float v) {
#pragma unroll
    for (int o = 1; o < 64; o <<= 1) v += __shfl_xor(v, o);
    return v;
}

enum { MAP_ID = 0, MAP_SWIGLU = 1, MAP_KVDOWN = 2, MAP_UQ = 3 };
template <int MAP> __device__ __forceinline__ int map_col(int np) {
    if (MAP == MAP_ID) return np;
    if (MAP == MAP_SWIGLU) { const int t = np >> 8, rem = np & 255, half = rem >> 7, c = rem & 127; return half * 2816 + 128 * t + c; }
    if (MAP == MAP_KVDOWN) { if (np < 256) return np; const int rem = np - 256, half = rem >> 7, c = rem & 127; return c < 32 ? 256 + 32 * half + c : -1; }
    if (np < 1024) { const int t = np >> 8, bj = (np >> 7) & 1, c = np & 127; return (2 * t + bj) * 192 + c; }
    { const int rem = np - 1024, t = rem >> 8, half = (rem >> 7) & 1, c = rem & 127, head = t * 4 + (c >> 5); return head * 192 + 128 + 32 * half + (c & 31); }
}
template <int MAP> __device__ __forceinline__ void conv_item(const float* W, int K, int Nsrc, int NP, bf16* WT, const float* gain, int item, int lane) {
    const int nblk = NP / 128, kb0 = item / nblk, nb = item % nblk, k0 = 64 * kb0, n0 = 128 * nb;
    const int nq = lane & 31, kh = lane >> 5;
    const int s32 = map_col<MAP>(n0 + ((4 * nq) & ~31));
    const int src = s32 + ((4 * nq) & 31);
    bf16* dst = WT + (size_t)(n0 + 4 * nq) * K + k0 + 8 * kh;
    if (s32 < 0) {
#pragma unroll
        for (int kk = 0; kk < 4; ++kk)
#pragma unroll
            for (int c = 0; c < 4; ++c) *(u32x4*)(dst + (size_t)c * K + 16 * kk) = (u32x4){0u, 0u, 0u, 0u};
        return;
    }
#pragma unroll
    for (int kp = 0; kp < 2; ++kp) {
        f32x4 v[2][8]; f32x4 g0[2], g1[2];
#pragma unroll
        for (int k2 = 0; k2 < 2; ++k2) { const int kb = k0 + 16 * (2 * kp + k2) + 8 * kh;
#pragma unroll
            for (int j = 0; j < 8; ++j) v[k2][j] = __builtin_nontemporal_load((const f32x4*)(W + (size_t)(kb + j) * Nsrc + src));
            if (gain) { g0[k2] = *(const f32x4*)(gain + kb); g1[k2] = *(const f32x4*)(gain + kb + 4); } else { g0[k2] = (f32x4){1.f, 1.f, 1.f, 1.f}; g1[k2] = g0[k2]; } }
#pragma unroll
        for (int k2 = 0; k2 < 2; ++k2)
#pragma unroll
            for (int c = 0; c < 4; ++c) { u32x4 o;
                o.x = pk2(v[k2][0][c] * g0[k2][0], v[k2][1][c] * g0[k2][1]); o.y = pk2(v[k2][2][c] * g0[k2][2], v[k2][3][c] * g0[k2][3]);
                o.z = pk2(v[k2][4][c] * g1[k2][0], v[k2][5][c] * g1[k2][1]); o.w = pk2(v[k2][6][c] * g1[k2][2], v[k2][7][c] * g1[k2][3]);
                *(u32x4*)(dst + (size_t)c * K + 16 * (2 * kp + k2)) = o; }
    }
}

struct Args {
    const float* in[20]; float* out; unsigned char* ws; int ph_lo, ph_hi, use_cg, pad;
};

template <int MLA> __device__ __forceinline__ void attn_phase(LAS unsigned char* lds, int G, int cwg,
        const bf16* Q0, const bf16* Q1, const bf16* K0, const bf16* K1, const bf16* V, bf16* O, const float* rel_table) {
    constexpr int DQK = MLA ? 192 : 64, DV = MLA ? 128 : 64, NH = MLA ? 8 : 16, NKS = DQK / 16, NDB = DV / 32;
    constexpr int KROW = DQK + 8, VROW = DV + 32;
    constexpr int KCH = DQK / 8, NKC = 64 * KCH / NTHREADS;
    constexpr int NVC = 64 * (DV / 8) / NTHREADS;
    LAS bf16* Ks = (LAS bf16*)lds;
    LAS bf16* Vt = (LAS bf16*)(lds + 64 * KROW * 2);
    LAS float* Bt = (LAS float*)(lds + 64 * KROW * 2 + 64 * VROW * 2);
    int tid_ = threadIdx.x; asm volatile("" : "+v"(tid_));
    const int tid = tid_, lane = tid & 63, wid = __builtin_amdgcn_readfirstlane(tid >> 6), r32 = lane & 31, hi = lane >> 5;
    const int nunits = BATCH * NH * 8;
    const int pi = 16 * (r32 >> 4) + 8 * ((r32 >> 2) & 1) + 4 * ((r32 >> 3) & 1) + (r32 & 3);
    for (int L = cwg; L < nunits; L += G) {
        int b, h, grp;
        if (MLA) { const int pair = L / (BATCH * NH), bh = L % (BATCH * NH); b = bh / NH; h = bh % NH; grp = (0x10235467 >> (4 * pair)) & 7; }
        else { grp = L / (BATCH * NH); const int bh = L % (BATCH * NH); b = bh / NH; h = bh % NH; }
        const int tok0 = b * SEQ;
        const int cq = 4 * grp + (wid >> 1);
        const int qrow = tok0 + 256 * grp + 32 * wid + r32;
        const int kc_lo = MLA ? 0 : ((4 * grp - 8) > 0 ? (4 * grp - 8) : 0), kc_hi = 4 * grp + 3;
        bf16x8 qf[NKS];
#pragma unroll
        for (int ks = 0; ks < NKS; ++ks) {
            const bf16* src;
            if (!MLA) src = Q0 + (size_t)qrow * 1024 + h * 64 + 16 * ks + 8 * hi;
            else src = (ks < 8) ? Q0 + (size_t)qrow * 1024 + h * 128 + 16 * ks + 8 * hi : Q1 + (size_t)qrow * 512 + h * 64 + 16 * (ks - 8) + 8 * hi;
            qf[ks] = __builtin_nontemporal_load((const bf16x8*)src);
        }
        if (!MLA) { __syncthreads(); for (int i = tid; i < 257; i += NTHREADS) Bt[i] = rel_table[h * 257 + i] * 1.4426950408889634f; }
        f32x16 o[NDB];
#pragma unroll
        for (int db = 0; db < NDB; ++db)
#pragma unroll
            for (int r = 0; r < 16; ++r) o[db][r] = 0.f;
        float mrun = -1e30f, lrun = 0.f;
        u32x4 kreg[NKC], vreg[NVC];
        auto prefetch = [&](int kc) {
            const int t0 = tok0 + 64 * kc;
#pragma unroll
            for (int j = 0; j < NKC; ++j) { const int c = tid + NTHREADS * j, row = c / KCH, ch = c % KCH; const bf16* src;
                if (!MLA) src = K0 + (size_t)(t0 + row) * 1024 + h * 64 + ch * 8;
                else src = (ch < 16) ? K0 + (size_t)(t0 + row) * 1024 + h * 128 + ch * 8 : K1 + (size_t)(t0 + row) * 64 + (ch - 16) * 8;
                kreg[j] = *(const u32x4*)src; }
#pragma unroll
            for (int j = 0; j < NVC; ++j) { const int c = tid + NTHREADS * j, kv = c / (DV / 8), dch = c % (DV / 8);
                vreg[j] = *(const u32x4*)(V + (size_t)(t0 + kv) * 1024 + h * DV + dch * 8); }
        };
        prefetch(kc_lo);
        for (int kc = kc_lo; kc <= kc_hi; ++kc) {
            __syncthreads();
#pragma unroll
            for (int j = 0; j < NKC; ++j) { const int c = tid + NTHREADS * j, row = c / KCH, ch = c % KCH; *(LAS u32x4*)(Ks + row * KROW + ch * 8) = kreg[j]; }
#pragma unroll
            for (int j = 0; j < NVC; ++j) { const int c = tid + NTHREADS * j, kv = c / (DV / 8), dch = c % (DV / 8); *(LAS u32x4*)(Vt + kv * VROW + dch * 8) = vreg[j]; }
            __syncthreads();
            if (kc < kc_hi) prefetch(kc + 1);
            const bool active = MLA ? (kc <= cq) : (kc <= cq && kc >= cq - 8);
            if (active) {
                f32x16 st[2];
#pragma unroll
                for (int p = 0; p < 2; ++p)
#pragma unroll
                    for (int r = 0; r < 16; ++r) st[p][r] = 0.f;
                {
                    constexpr int NF = 2 * NKS, KLA = MLA ? 4 : 6;
                    bf16x8 kf[NF];
#define KREAD(f) kf[f] = *(const LAS bf16x8*)(Ks + (32 * ((f) & 1) + pi) * KROW + 16 * ((f) >> 1) + 8 * hi)
#pragma unroll
                    for (int f = 0; f < KLA; ++f) KREAD(f);
                    __builtin_amdgcn_sched_barrier(0);
#pragma unroll
                    for (int g = 0; g < NKS; ++g) {
                        st[0] = __builtin_amdgcn_mfma_f32_32x32x16_bf16(kf[2 * g], qf[g], st[0], 0, 0, 0);
                        st[1] = __builtin_amdgcn_mfma_f32_32x32x16_bf16(kf[2 * g + 1], qf[g], st[1], 0, 0, 0);
                        if (2 * g + KLA < NF) KREAD(2 * g + KLA);
                        if (2 * g + KLA + 1 < NF) KREAD(2 * g + KLA + 1);
                        __builtin_amdgcn_sched_barrier(0);
                    }
#undef KREAD
                }
                if (!MLA) {
                    if (cq - kc >= 3) {
                        const float cbias = Bt[256];
#pragma unroll
                        for (int p = 0; p < 2; ++p)
#pragma unroll
                            for (int r = 0; r < 16; ++r) st[p][r] += cbias;
                    } else {
                        const int base = 64 * (cq - kc) + 32 * (wid & 1) + r32 - 8 * hi + 128;
#pragma unroll
                        for (int p = 0; p < 2; ++p)
#pragma unroll
                            for (int r = 0; r < 16; ++r) { int idx = base - (32 * p + 16 * (r >> 3) + (r & 7)); idx = idx > 256 ? 256 : idx; st[p][r] += Bt[idx]; }
                    }
                }
                float mx = st[0][0];
#pragma unroll
                for (int p = 0; p < 2; ++p)
#pragma unroll
                    for (int r = 0; r < 16; ++r) mx = fmaxf(mx, st[p][r]);
                mx = fmaxf(mx, __shfl_xor(mx, 32));
                const float mnew = fmaxf(mrun, mx), alpha = __builtin_amdgcn_exp2f(mrun - mnew);
                mrun = mnew;
                float rsum = 0.f;
#pragma unroll
                for (int p = 0; p < 2; ++p)
#pragma unroll
                    for (int r = 0; r < 16; ++r) { st[p][r] = __builtin_amdgcn_exp2f(st[p][r] - mnew); rsum += st[p][r]; }
                lrun = lrun * alpha + rsum;
                if (__any(alpha != 1.0f)) {
#pragma unroll
                for (int db = 0; db < NDB; ++db)
#pragma unroll
                    for (int r = 0; r < 16; ++r) o[db][r] *= alpha;
                }
                bf16x8 pf[2][2];
#pragma unroll
                for (int p = 0; p < 2; ++p)
#pragma unroll
                    for (int s = 0; s < 2; ++s) { u32x4 w; w.x = pg8::cvt_pk_bf16(st[p][8 * s + 0], st[p][8 * s + 1]); w.y = pg8::cvt_pk_bf16(st[p][8 * s + 2], st[p][8 * s + 3]);
                        w.z = pg8::cvt_pk_bf16(st[p][8 * s + 4], st[p][8 * s + 5]); w.w = pg8::cvt_pk_bf16(st[p][8 * s + 6], st[p][8 * s + 7]); pf[p][s] = __builtin_bit_cast(bf16x8, w); }
                {
                    constexpr int NFV = 4 * NDB, VLA = MLA ? 2 : 4;
                    bf16x8 vf[NFV];
                    const LAS bf16* vbase = Vt + (8 * hi + ((lane & 15) >> 2)) * VROW + 16 * ((lane >> 4) & 1) + 4 * (lane & 3);
#define VREAD(f) do { const LAS bf16* vp_ = vbase + (32 * (((f) / NDB) >> 1) + 16 * (((f) / NDB) & 1)) * VROW + 32 * ((f) % NDB); \
                        const s16x4 vlo_ = __builtin_bit_cast(s16x4, __builtin_amdgcn_ds_read_tr16_b64_v4i16((LAS s16x4*)vp_)); \
                        const s16x4 vhi_ = __builtin_bit_cast(s16x4, __builtin_amdgcn_ds_read_tr16_b64_v4i16((LAS s16x4*)(vp_ + 4 * VROW))); \
                        vf[f] = __builtin_shufflevector(vlo_, vhi_, 0, 1, 2, 3, 4, 5, 6, 7); } while (0)
#pragma unroll
                    for (int f = 0; f < VLA; ++f) VREAD(f);
                    __builtin_amdgcn_sched_barrier(0);
#pragma unroll
                    for (int f = 0; f < NFV; ++f) {
                        o[f % NDB] = __builtin_amdgcn_mfma_f32_32x32x16_bf16(vf[f], pf[(f / NDB) >> 1][(f / NDB) & 1], o[f % NDB], 0, 0, 0);
                        if (f + VLA < NFV) VREAD(f + VLA);
                        __builtin_amdgcn_sched_barrier(0);
                    }
#undef VREAD
                }
            }
        }
        const float ltot = lrun + __shfl_xor(lrun, 32), rl = 1.0f / ltot;
        bf16* orow = O + (size_t)qrow * 1024 + h * DV;
#pragma unroll
        for (int db = 0; db < NDB; ++db)
#pragma unroll
            for (int j = 0; j < 2; ++j) {
                const unsigned ax = pg8::cvt_pk_bf16(o[db][8 * j] * rl, o[db][8 * j + 1] * rl), ay = pg8::cvt_pk_bf16(o[db][8 * j + 2] * rl, o[db][8 * j + 3] * rl);
                const unsigned bx = pg8::cvt_pk_bf16(o[db][8 * j + 4] * rl, o[db][8 * j + 5] * rl), by = pg8::cvt_pk_bf16(o[db][8 * j + 6] * rl, o[db][8 * j + 7] * rl);
                const auto sx = __builtin_amdgcn_permlane32_swap(ax, bx, false, false); const auto sy = __builtin_amdgcn_permlane32_swap(ay, by, false, false);
                u32x4 w; w.x = sx[0]; w.y = sy[0]; w.z = sx[1]; w.w = sy[1];
                *(u32x4*)(orow + 32 * db + 16 * j + 8 * hi) = w; }
        __syncthreads();
    }
}

#define RLX_AGENT __ATOMIC_RELAXED, __HIP_MEMORY_SCOPE_AGENT
#define XB_TMO      128
#define XB_XCNT(j)  (256  + 64 * (j))
#define XB_XSUB(j)  (1280 + 64 * (j))
#define XB_XGEN(j)  (2304 + 64 * (j))
#define XB_TOP      3328
#define XB_TOPGEN   3392
#define XCD_BAR_WORDS 3456
#define XB_SPIN_CAP (1u << 18)

__device__ __forceinline__ unsigned xb_ld(unsigned* p)              { return __hip_atomic_load(p, __ATOMIC_RELAXED, __HIP_MEMORY_SCOPE_AGENT); }
__device__ __forceinline__ unsigned xb_add(unsigned* p, unsigned v) { return __hip_atomic_fetch_add(p, v, __ATOMIC_RELAXED, __HIP_MEMORY_SCOPE_AGENT); }
__device__ __forceinline__ unsigned xb_xcc_id() { return (unsigned)__builtin_amdgcn_s_getreg((3 << 11) | 20) & 0xFu; }
#define XB_SPIN(cond, bar) do { unsigned _sp = 0; while (cond) { __builtin_amdgcn_s_sleep(1); \
    if ((++_sp & 255u) == 0u) { if (xb_ld(&(bar)[XB_TMO])) break; if (_sp > XB_SPIN_CAP) { atomicAdd(&(bar)[XB_TMO], 1u); break; } } } } while (0)

struct XcdBarrier {
    unsigned* bar; unsigned x;
    volatile LAS unsigned* st;
};

__device__ __forceinline__ XcdBarrier xcd_barrier_post(unsigned* bar, volatile LAS unsigned* st) {
    XcdBarrier b; b.bar = bar; b.x = xb_xcc_id(); b.st = st;
    if (threadIdx.x == 0) (void)xb_add(&bar[XB_XCNT(b.x)], 1u);
    return b;
}
__device__ __forceinline__ void xcd_barrier_complete(unsigned* bar, unsigned x, unsigned& nloc, unsigned& nx) {
    const unsigned G = gridDim.x * gridDim.y * gridDim.z;
    unsigned sum, cnt, mine, sp = 0u;
    for (;;) {
        sum = 0u; cnt = 0u; mine = 0u;
#pragma unroll
        for (unsigned j = 0; j < 16; ++j) { const unsigned c = xb_ld(&bar[XB_XCNT(j)]); sum += c; cnt += (c > 0u) ? 1u : 0u; mine = (j == x) ? c : mine; }
        if (sum == G) break;
        __builtin_amdgcn_s_sleep(1);
        if ((++sp & 255u) == 0u) { if (xb_ld(&bar[XB_TMO])) break; if (sp > XB_SPIN_CAP) { atomicAdd(&bar[XB_TMO], 1u); break; } }
    }
    nloc = mine > 0u ? mine : 1u; nx = cnt > 0u ? cnt : 1u;
}

__device__ __forceinline__ void xcd_barrier(const XcdBarrier& b) {
    asm volatile("s_waitcnt vmcnt(0)" ::: "memory");
    __syncthreads();
    if (threadIdx.x == 0) {
        unsigned* bar = b.bar;
        __builtin_amdgcn_s_waitcnt(0);
        unsigned nloc = b.st[0], nx = b.st[1];
        if (nloc == 0u) { xcd_barrier_complete(bar, b.x, nloc, nx); b.st[0] = nloc; b.st[1] = nx; }
        const unsigned old = xb_add(&bar[XB_XSUB(b.x)], 1u);
        const unsigned gen = old / nloc;
        if (old + 1u == (gen + 1u) * nloc) {
            __builtin_amdgcn_fence(__ATOMIC_RELEASE, "agent");
            asm volatile("s_waitcnt vmcnt(0)" ::: "memory");
            const unsigned og = xb_add(&bar[XB_TOP], 1u);
            const unsigned tg = og / nx;
            if (og + 1u == (tg + 1u) * nx) xb_add(&bar[XB_TOPGEN], 1u);
            else XB_SPIN(xb_ld(&bar[XB_TOPGEN]) == tg, bar);
            __builtin_amdgcn_fence(__ATOMIC_ACQUIRE, "agent");
            xb_add(&bar[XB_XGEN(b.x)], 1u);
            asm volatile("s_waitcnt vmcnt(0)" ::: "memory");
        } else {
            XB_SPIN(xb_ld(&bar[XB_XGEN(b.x)]) == gen, bar);
            __builtin_amdgcn_fence(__ATOMIC_ACQUIRE, "agent");
            asm volatile("s_waitcnt vmcnt(0)" ::: "memory");
        }
    }
    __syncthreads();
}

__device__ __forceinline__ const void* karg_ptr(int i) {
    const __attribute__((address_space(4))) char* kp = (const __attribute__((address_space(4))) char*)__builtin_amdgcn_kernarg_segment_ptr();
    asm volatile("" : "+s"(kp));
    return *(const void* const __attribute__((address_space(4)))*)(kp + 8 * i);
}
#define KARG(i) ((const float*)karg_ptr(i))
#define WSP ((unsigned char*)karg_ptr(21))
#define HRES ((float*)karg_ptr(20))
#define SSQ ((float*)(WSP + WS_SSQ))
#define ROPE ((float*)(WSP + WS_ROPE))
#define WPTR(off) ((bf16*)(WSP + WS_W + (off)))
#define BPTR(off) ((bf16*)(WSP + (off)))
template <int PASS> __device__ __forceinline__ void convert_weights(int lane, int gw, int NGW) {
        constexpr int I_FFIN = 16 * 44, I_FFOUT = 44 * 8, I_QKV = 16 * 24, I_WO = 16 * 8, I_KVD = 16 * 4, I_KVU = 4 * 16, I_DQ = 16 * 6, I_UQ = 12 * 12;
        constexpr int NITEMS = PASS == 0 ? (2 * I_FFIN + 2 * I_FFOUT + I_QKV + I_WO) : (2 * I_FFIN + 2 * I_FFOUT + I_WO + I_KVD + I_KVU + I_DQ + I_UQ);
        for (int it = gw; it < NITEMS; it += NGW) {
            int r = it;
            if (r < 2 * I_FFIN) { const int which = r / I_FFIN, layer = PASS, w = 2 * PASS + which; r -= which * I_FFIN;
                conv_item<MAP_SWIGLU>((which ? KARG(6) : KARG(2)) + (size_t)layer * 1024 * 5632, 1024, 5632, 5632, WPTR(WO_FFIN0) + (size_t)w * (W_FFIN / 2), (which ? KARG(5) : KARG(1)) + layer * 1024, r, lane); continue; }
            r -= 2 * I_FFIN;
            if (r < 2 * I_FFOUT) { const int which = r / I_FFOUT, layer = PASS, w = 2 * PASS + which; r -= which * I_FFOUT;
                conv_item<MAP_ID>((which ? KARG(7) : KARG(3)) + (size_t)layer * 2816 * 1024, 2816, 1024, 1024, WPTR(WO_FFOUT0) + (size_t)w * (W_FFOUT / 2), nullptr, r, lane); continue; }
            r -= 2 * I_FFOUT;
            if (PASS == 0) {
                if (r < I_QKV) { conv_item<MAP_ID>(KARG(8), 1024, 3072, 3072, WPTR(WO_QKV), KARG(4), r, lane); continue; } r -= I_QKV;
                conv_item<MAP_ID>(KARG(10), 1024, 1024, 1024, WPTR(WO_AWO), nullptr, r, lane);
            } else {
                if (r < I_WO) { conv_item<MAP_ID>(KARG(18), 1024, 1024, 1024, WPTR(WO_BWO), nullptr, r, lane); continue; } r -= I_WO;
                if (r < I_KVD) { conv_item<MAP_KVDOWN>(KARG(12), 1024, 320, 512, WPTR(WO_KVD), KARG(11), r, lane); continue; } r -= I_KVD;
                if (r < I_KVU) { conv_item<MAP_ID>(KARG(14), 256, 2048, 2048, WPTR(WO_KVU), KARG(13), r, lane); continue; } r -= I_KVU;
                if (r < I_DQ) { conv_item<MAP_ID>(KARG(15), 1024, 768, 768, WPTR(WO_DQ), KARG(4) + 1024, r, lane); continue; } r -= I_DQ;
                conv_item<MAP_UQ>(KARG(17), 768, 1536, 1536, WPTR(WO_UQ), KARG(16), r, lane);
            }
        }
}
__device__ __forceinline__ void prologue_phase(LAS unsigned char* lds, int tid, int lane, int wave, int G, int bx, int gw, int NGW) {
        convert_weights<0>(lane, gw, NGW);
        { const float* x = KARG(0); bf16* hb = BPTR(WS_HB); float* ssq = SSQ; float* rope = ROPE;
        for (int m = gw; m < M; m += NGW) {
            const f32x4* xr = (const f32x4*)(x + (size_t)m * D) + lane; f32x4 v[4]; float s = 0.f;
#pragma unroll
            for (int j = 0; j < 4; ++j) { v[j] = __builtin_nontemporal_load(xr + 64 * j); s += pg8::sq4(v[j]); }
            s = wave_sum(s);
            u32x2* o8 = (u32x2*)(hb + (size_t)m * D) + lane;
#pragma unroll
            for (int j = 0; j < 4; ++j) { u32x2 w; w.x = pk2(v[j][0], v[j][1]); w.y = pk2(v[j][2], v[j][3]); o8[64 * j] = w; }
            if (lane == 0) ssq[m] = s;
        }
        for (int i = bx * NTHREADS + tid; i < 8 * M; i += G * NTHREADS) ssq[M + i] = 0.f;
        for (int i = bx * NTHREADS + tid; i < 2048 * 32; i += G * NTHREADS) { const int pos = i >> 5, j = i & 31;
            const float freq = powf(10000.0f, -(float)j / 32.0f); const float ang = (float)pos * freq; rope[2 * i] = cosf(ang); rope[2 * i + 1] = sinf(ang); }
        }
        __syncthreads();
    }
#ifndef PROBE_PRO
#define PROBE_PRO
#endif
__global__ void __launch_bounds__(NTHREADS, 2) yoco_fwd(Args args) {
    extern __shared__ __attribute__((aligned(16))) unsigned char lds_raw[];
    LAS unsigned char* lds = (LAS unsigned char*)lds_raw;
    cg::grid_group grid = cg::this_grid();
    const int tid = threadIdx.x, lane = tid & 63, wave = __builtin_amdgcn_readfirstlane(tid >> 6);
    const int G = gridDim.x, bx = blockIdx.x;
    for (int u = tid; u < 64; u += NTHREADS) ((LAS unsigned*)(lds + MISC_OFF))[u] = 0u;
    __syncthreads();
    XcdBarrier bar = xcd_barrier_post((unsigned*)((unsigned char*)karg_ptr(21) + WS_CTL), (volatile LAS unsigned*)(lds + MISC_OFF));
    const int gw = bx * NWAVES + wave, NGW = G * NWAVES;
    const int lo = args.ph_lo, hi = args.ph_hi, use_cg = args.use_cg;
#define IN(k) (lo <= (k) && (k) < hi)
#define SEAM(k) do { if (IN(k) && IN((k) + 1)) { if (use_cg) grid.sync(); else xcd_barrier(bar); } } while (0)
    constexpr float C2A = 0.125f * 1.4426950408889634f;
    constexpr float C2B = 0.07216878364870322f * 1.4426950408889634f;

    if (IN(0)) { prologue_phase(lds, tid, lane, wave, G, bx, gw, NGW); PROBE_PRO }
    SEAM(0);
#define GEMM_PHASE(MODE, Aptr, Bptr, NN, KK, EPI) do { pg8::Gemm g_{Aptr, Bptr, M, NN, KK}; pg8::StaticOrder S_; S_.init(M, NN, G, bx); \
        pg8::gemm_phase<pg8::Epi<MODE>, pg8::StaticOrder, true, true>(lds, g_, S_, EPI); } while (0)
#define FFN_IN(kssq, widx) do { pg8::Epi<pg8::EM_SWIGLU> E{SSQ + (size_t)(kssq) * M, i1024, BPTR(WS_ACT), nullptr, nullptr, nullptr, nullptr, nullptr, 1.f, nullptr}; \
        GEMM_PHASE(pg8::EM_SWIGLU, BPTR(WS_HB), WPTR(WO_FFIN0 + (widx) * W_FFIN), 5632, 1024, E); } while (0)
#define FFN_OUT(MODE, HOLD, kssq, widx) do { pg8::Epi<MODE> E{nullptr, 0.f, BPTR(WS_HB), nullptr, nullptr, HOLD, HRES, SSQ + (size_t)(kssq) * M, 0.5f, nullptr}; \
        GEMM_PHASE(MODE, BPTR(WS_ACT), WPTR(WO_FFOUT0 + (widx) * W_FFOUT), 1024, 2816, E); } while (0)
#define WO_PROJ(Aoff, Woff, kssq) do { pg8::Epi<pg8::EM_RES> E{nullptr, 0.f, BPTR(WS_HB), nullptr, nullptr, nullptr, nullptr, SSQ + (size_t)(kssq) * M, 1.0f, nullptr}; \
        GEMM_PHASE(pg8::EM_RES, BPTR(Aoff), WPTR(Woff), 1024, 1024, E); } while (0)
    const float i1024 = 1.0f / 1024.0f;
    if (IN(1)) FFN_IN(0, 0);
    SEAM(1);
    if (IN(2)) FFN_OUT(pg8::EM_RES, nullptr, 1, 0);
    SEAM(2);
    if (IN(3)) { pg8::Epi<pg8::EM_QKV> E{SSQ + 1 * M, i1024, BPTR(WS_Q), nullptr, nullptr, nullptr, nullptr, nullptr, C2A, nullptr}; GEMM_PHASE(pg8::EM_QKV, BPTR(WS_HB), WPTR(WO_QKV), 3072, 1024, E); }
    SEAM(3);
    if (IN(4)) { attn_phase<0>(lds, G, bx, BPTR(WS_Q), nullptr, BPTR(WS_K), nullptr, BPTR(WS_V), BPTR(WS_Q), KARG(9)); convert_weights<1>(lane, gw, NGW); }
    SEAM(4);
    if (IN(5)) WO_PROJ(WS_Q, WO_AWO, 2);
    SEAM(5);
    if (IN(6)) FFN_IN(2, 1);
    SEAM(6);
    if (IN(7)) FFN_OUT(pg8::EM_RES, nullptr, 3, 1);
    SEAM(7);
    if (IN(8)) {
        { pg8::Epi<pg8::EM_KVDOWN> E{SSQ + 3 * M, i1024, BPTR(WS_CKV), BPTR(WS_KR), nullptr, nullptr, nullptr, SSQ + 4 * M, 1.f, ROPE}; GEMM_PHASE(pg8::EM_KVDOWN, BPTR(WS_HB), WPTR(WO_KVD), 512, 1024, E); }
        FFN_IN(3, 2);
    }
    SEAM(8);
    if (IN(9)) {
        { pg8::Epi<pg8::EM_KVUP> E{SSQ + 4 * M, 1.0f / 256.0f, BPTR(WS_KN), BPTR(WS_VB), nullptr, nullptr, nullptr, nullptr, 1.f, nullptr}; GEMM_PHASE(pg8::EM_KVUP, BPTR(WS_CKV), WPTR(WO_KVU), 2048, 256, E); }
        FFN_OUT(pg8::EM_RES, nullptr, 5, 2);
    }
    SEAM(9);
    if (IN(10)) { pg8::Epi<pg8::EM_DQ> E{SSQ + 5 * M, i1024, BPTR(WS_CQ), nullptr, nullptr, nullptr, nullptr, SSQ + 6 * M, 1.f, nullptr}; GEMM_PHASE(pg8::EM_DQ, BPTR(WS_HB), WPTR(WO_DQ), 768, 1024, E); }
    SEAM(10);
    if (IN(11)) { pg8::Epi<pg8::EM_UQ> E{SSQ + 6 * M, 1.0f / 768.0f, BPTR(WS_QN), BPTR(WS_QR), nullptr, nullptr, nullptr, nullptr, C2B, ROPE}; GEMM_PHASE(pg8::EM_UQ, BPTR(WS_CQ), WPTR(WO_UQ), 1536, 768, E); }
    SEAM(11);
    if (IN(12)) attn_phase<1>(lds, G, bx, BPTR(WS_QN), BPTR(WS_QR), BPTR(WS_KN), BPTR(WS_KR), BPTR(WS_VB), BPTR(WS_QN), nullptr);
    SEAM(12);
    if (IN(13)) WO_PROJ(WS_QN, WO_BWO, 7);
    SEAM(13);
    if (IN(14)) FFN_IN(7, 3);
    SEAM(14);
    if (IN(15)) FFN_OUT(pg8::EM_RES_F, nullptr, 8, 3);
    SEAM(15);
    if (IN(16)) {
        float* hres = HRES; const float* ssq = SSQ; const float* final_norm = KARG(19);
        for (int m = gw; m < M; m += NGW) {
            const float rs = __builtin_amdgcn_rsqf(ssq[8 * M + m] * i1024 + pg8::RMS_EPS);
            f32x4* xr = (f32x4*)(hres + (size_t)m * D) + lane; const f32x4* gr = (const f32x4*)final_norm + lane;
#pragma unroll
            for (int j = 0; j < 4; ++j) { const f32x4 v = xr[64 * j], g = gr[64 * j]; __builtin_nontemporal_store(v * rs * g, xr + 64 * j); }
        }
    }
#undef IN
#undef SEAM
}

#ifndef MK_MULTI
#define MK_MULTI 0
#endif
extern "C" void kernel_launch(void* const* d_in, const int* in_sizes, int n_in, void* d_out, int out_size, void* d_ws, size_t ws_size, hipStream_t stream) {
    static int grid = 0;
    if (grid == 0) {
        int dev = 0, cus = 0, per_cu = 0;
        hipGetDevice(&dev);
        hipDeviceGetAttribute(&cus, hipDeviceAttributeMultiprocessorCount, dev);
        hipFuncSetAttribute((const void*)yoco_fwd, hipFuncAttributeMaxDynamicSharedMemorySize, LDS_BYTES);
        hipOccupancyMaxActiveBlocksPerMultiprocessor(&per_cu, (const void*)yoco_fwd, NTHREADS, LDS_BYTES);
        if (per_cu < 1) per_cu = 1;
        grid = cus * 1;
        if (n_in != 20 || ws_size < WS_END) { fprintf(stderr, "kernel_launch: unexpected n_in %d / ws_size %zu (need %zu)\n", n_in, ws_size, (size_t)WS_END); }
        (void)hipGetLastError();
    }
    (void)hipMemsetAsync((char*)d_ws + WS_CTL, 0, CTL_BYTES, stream);
    Args a{};
    for (int i = 0; i < 20; ++i) a.in[i] = (const float*)d_in[i];
    a.out = (float*)d_out; a.ws = (unsigned char*)d_ws;
#if MK_MULTI
    for (int p = 0; p < 17; ++p) { a.ph_lo = p; a.ph_hi = p + 1; void* kargs[] = {&a};
        hipLaunchCooperativeKernel((const void*)yoco_fwd, dim3(grid), dim3(NTHREADS), kargs, LDS_BYTES, stream); }
#else
    a.ph_lo = 0; a.ph_hi = 17; void* kargs[] = {&a};
    hipError_t e = hipLaunchCooperativeKernel((const void*)yoco_fwd, dim3(grid), dim3(NTHREADS), kargs, LDS_BYTES, stream);
    if (e != hipSuccess) fprintf(stderr, "cooperative launch failed: %s (grid %d)\n", hipGetErrorString(e), grid);
#endif
}
```

```cpp
#include <hip/hip_runtime.h>
namespace pg8 {
#define PG8_LAS __attribute__((address_space(3)))
typedef unsigned short bf16_t;
typedef short bf16x8 __attribute__((ext_vector_type(8)));
typedef float f32x4 __attribute__((ext_vector_type(4)));
typedef unsigned u32x4 __attribute__((ext_vector_type(4)));
constexpr int BM = 256, BK = 64, HALF = 128, HTB = HALF * BK * 2  , STAGE_BYTES = 8 * HTB, NXCD = 8, WGM = 8;

__host__ __device__ __forceinline__ int lds_byte(int r, int c) { const int st = (r >> 4) * 2 + (c >> 5), rr = r & 15, cc = c & 31, ob = rr * 64 + cc * 2; return st * 1024 + (ob ^ (((ob >> 9) & 1) << 5)); }
__host__ __device__ __forceinline__ void stage_rc(int b, int& R, int& C) { const int st = b / 1024, sb = b % 1024, swz = sb ^ (((sb >> 9) & 1) << 5); R = (st >> 1) * 16 + swz / 64; C = (st & 1) * 32 + (swz % 64) / 2; }
__host__ __device__ __forceinline__ int perm32(int rho) { const int n = rho >> 4, i = rho & 15; return 8 * (i >> 2) + 4 * n + (i & 3); }

struct Unit { int pm, pn; };
struct Gemm { const bf16_t* A; const bf16_t* Bt; int M, N, K; };

struct StaticOrder {
    int nM, nN, nwg, G, c;
    __host__ __device__ void init(int M, int N, int G_, int c_) { nM = M / BM; nN = N / BM; nwg = nM * nN; G = G_; c = c_; }
    __host__ __device__ bool next(int i, Unit& u) const {
        const long L = (long)i * G + c; if (L >= nwg) return false;
        int wgid = (int)L; { const int q = nwg / NXCD, r = nwg % NXCD, xcd = wgid % NXCD, off = wgid / NXCD; wgid = (xcd < r ? xcd * (q + 1) : r * (q + 1) + (xcd - r) * q) + off; }
        const int nig = WGM * nN, gid = wgid / nig, fm = gid * WGM, gsz = (nM - fm) < WGM ? (nM - fm) : WGM;
        u.pm = fm + ((wgid % nig) % gsz); u.pn = (wgid % nig) / gsz; return true;
    }
    __device__ __forceinline__ void a_ready(const Unit&) const {}
    __device__ __forceinline__ void done(const Unit&) const {}
};


__device__ __forceinline__ unsigned cvt_pk_bf16(float lo, float hi) {
    typedef float f2_t __attribute__((ext_vector_type(2))); typedef __bf16 b2_t __attribute__((ext_vector_type(2)));
    f2_t v = {lo, hi}; b2_t b = __builtin_convertvector(v, b2_t); return __builtin_bit_cast(unsigned, b);
}
__device__ __forceinline__ u32x4 pack8(const f32x4 a, const f32x4 b) { u32x4 w; w.x = cvt_pk_bf16(a[0], a[1]); w.y = cvt_pk_bf16(a[2], a[3]); w.z = cvt_pk_bf16(b[0], b[1]); w.w = cvt_pk_bf16(b[2], b[3]); return w; }
__device__ __forceinline__ float sq4(const f32x4 a) { return (a[0] * a[0] + a[1] * a[1]) + (a[2] * a[2] + a[3] * a[3]); }
__device__ __forceinline__ float silu_mul(float g, float u) { return g * __builtin_amdgcn_rcpf(1.0f + __builtin_amdgcn_exp2f(-1.4426950408889634f * g)) * u; }

__device__ __forceinline__ f32x4 swiglu4(const f32x4 g, const f32x4 u, float rs) {
    const f32x4 t = g * (rs * -1.4426950408889634f); f32x4 e;
#pragma unroll
    for (int i = 0; i < 4; ++i) e[i] = __builtin_amdgcn_exp2f(t[i]);
    e = e + 1.0f; f32x4 r;
#pragma unroll
    for (int i = 0; i < 4; ++i) r[i] = __builtin_amdgcn_rcpf(e[i]);
    return (g * u) * (r * (rs * rs));
}
enum { EM_SWIGLU = 0, EM_RES = 1, EM_QKV = 2, EM_KVDOWN = 3, EM_KVUP = 4, EM_DQ = 5, EM_UQ = 6, EM_RES_X = 7, EM_RES_F = 8 };
constexpr float RMS_EPS = 1e-6f;
template <int MODE> struct Epi {
    static constexpr bool PERM = true, AFTER_DRAIN = false;
    const float* ssq_in; float inv_n;
    bf16_t* o0; bf16_t* o1; bf16_t* o2;
    const float* hold; float* hnew;
    float* ssq_out;
    float scale;
    const float* rope;
    __device__ __forceinline__ void operator()(const f32x4 (&acc)[2][2][4][2], const Unit& u, int wr, int wc, int fr, int fq) const {
        const int cb = wc * 32 + 8 * fq;
        if (MODE == EM_RES || MODE == EM_RES_X || MODE == EM_RES_F) {
            if (MODE == EM_RES_X) {
#pragma unroll
                for (int ai = 0; ai < 2; ++ai) {
                    f32x4 pre[4][2][2];
#pragma unroll
                    for (int m = 0; m < 4; ++m)
#pragma unroll
                        for (int bj = 0; bj < 2; ++bj) { const size_t off = (size_t)(u.pm * BM + ai * HALF + wr * 64 + m * 16 + fr) * 1024 + u.pn * BM + bj * HALF + cb;
                            pre[m][bj][0] = *(const f32x4*)(hold + off); pre[m][bj][1] = *(const f32x4*)(hold + off + 4); }
#pragma unroll
                    for (int m = 0; m < 4; ++m) { const int row = u.pm * BM + ai * HALF + wr * 64 + m * 16 + fr; float s = 0.f;
#pragma unroll
                        for (int bj = 0; bj < 2; ++bj) { const size_t off = (size_t)row * 1024 + u.pn * BM + bj * HALF + cb;
                            const f32x4 n0 = pre[m][bj][0] + acc[ai][bj][m][0] * scale, n1 = pre[m][bj][1] + acc[ai][bj][m][1] * scale;
                            *(u32x4*)(o0 + off) = pack8(n0, n1); s += sq4(n0) + sq4(n1); }
                        s += __shfl_xor(s, 16); s += __shfl_xor(s, 32);
                        if (fq == 0) unsafeAtomicAdd(ssq_out + row, s); }
                }
                return;
            }
            u32x4 prw[2][4][2];
#pragma unroll
            for (int ai = 0; ai < 2; ++ai)
#pragma unroll
                for (int m = 0; m < 4; ++m)
#pragma unroll
                    for (int bj = 0; bj < 2; ++bj) prw[ai][m][bj] = *(const u32x4*)(o0 + (size_t)(u.pm * BM + ai * HALF + wr * 64 + m * 16 + fr) * 1024 + u.pn * BM + bj * HALF + cb);
#pragma unroll
            for (int ai = 0; ai < 2; ++ai)
#pragma unroll
                for (int m = 0; m < 4; ++m) { const int row = u.pm * BM + ai * HALF + wr * 64 + m * 16 + fr; float s = 0.f;
#pragma unroll
                    for (int bj = 0; bj < 2; ++bj) { const size_t off = (size_t)row * 1024 + u.pn * BM + bj * HALF + cb; const u32x4 w = prw[ai][m][bj];
                        const f32x4 p0 = (f32x4){__builtin_bit_cast(float, w.x << 16), __builtin_bit_cast(float, w.x & 0xffff0000u), __builtin_bit_cast(float, w.y << 16), __builtin_bit_cast(float, w.y & 0xffff0000u)};
                        const f32x4 p1 = (f32x4){__builtin_bit_cast(float, w.z << 16), __builtin_bit_cast(float, w.z & 0xffff0000u), __builtin_bit_cast(float, w.w << 16), __builtin_bit_cast(float, w.w & 0xffff0000u)};
                        const f32x4 n0 = p0 + acc[ai][bj][m][0] * scale, n1 = p1 + acc[ai][bj][m][1] * scale;
                        if (MODE == EM_RES_F) { *(f32x4*)(hnew + off) = n0; *(f32x4*)(hnew + off + 4) = n1; }
                        else *(u32x4*)(o0 + off) = pack8(n0, n1);
                        s += sq4(n0) + sq4(n1); }
                    s += __shfl_xor(s, 16); s += __shfl_xor(s, 32);
                    if (fq == 0) unsafeAtomicAdd(ssq_out + row, s); }
            return;
        }
#pragma unroll
        for (int ai = 0; ai < 2; ++ai)
#pragma unroll
            for (int m = 0; m < 4; ++m) {
                const int row = u.pm * BM + ai * HALF + wr * 64 + m * 16 + fr;
                float rs = 1.f;
                rs = __builtin_amdgcn_rsqf(ssq_in[row] * inv_n + RMS_EPS);
                if (MODE == EM_SWIGLU) {
                    f32x4 a0, a1;
#pragma unroll
                    for (int e = 0; e < 1; ++e) { a0 = swiglu4(acc[ai][0][m][0], acc[ai][1][m][0], rs); a1 = swiglu4(acc[ai][0][m][1], acc[ai][1][m][1], rs); }
                    *(u32x4*)(o0 + (size_t)row * 2816 + u.pn * 128 + cb) = pack8(a0, a1);
                } else if (MODE == EM_QKV) {
                    const int t = u.pn >> 2; bf16_t* base = o0 + (size_t)t * ((size_t)32768 * 1024); const float sc = (t == 0) ? rs * scale : rs;
#pragma unroll
                    for (int bj = 0; bj < 2; ++bj)
                        *(u32x4*)(base + (size_t)row * 1024 + (u.pn & 3) * BM + bj * HALF + cb) = pack8(acc[ai][bj][m][0] * sc, acc[ai][bj][m][1] * sc);
                } else if (MODE == EM_KVDOWN) {
                    if (u.pn == 0) {
                        float s = 0.f;
#pragma unroll
                        for (int bj = 0; bj < 2; ++bj) { const f32x4 v0 = acc[ai][bj][m][0] * rs, v1 = acc[ai][bj][m][1] * rs; s += sq4(v0) + sq4(v1);
                            *(u32x4*)(o0 + (size_t)row * 256 + bj * HALF + cb) = pack8(v0, v1); }
                        s += __shfl_xor(s, 16); s += __shfl_xor(s, 32);
                        if (fq == 0) unsafeAtomicAdd(ssq_out + row, s);
                    } else if (wc == 0) {
                        const int pos = row & 2047; const float* rp = rope + ((size_t)pos * 32 + 8 * fq) * 2;
                        f32x4 y0a, y0b, y1a, y1b;
#pragma unroll
                        for (int e = 0; e < 4; ++e) {
                            { const float x1 = rs * acc[ai][0][m][0][e], x2 = rs * acc[ai][1][m][0][e], c = rp[2 * e], sn = rp[2 * e + 1]; y0a[e] = x1 * c - x2 * sn; y1a[e] = x2 * c + x1 * sn; }
                            { const float x1 = rs * acc[ai][0][m][1][e], x2 = rs * acc[ai][1][m][1][e], c = rp[8 + 2 * e], sn = rp[8 + 2 * e + 1]; y0b[e] = x1 * c - x2 * sn; y1b[e] = x2 * c + x1 * sn; }
                        }
                        *(u32x4*)(o1 + (size_t)row * 64 + 8 * fq) = pack8(y0a, y0b);
                        *(u32x4*)(o1 + (size_t)row * 64 + 32 + 8 * fq) = pack8(y1a, y1b);
                    }
                } else if (MODE == EM_KVUP) {
                    *(u32x4*)(o0 + (size_t)row * 1024 + u.pn * 128 + cb) = pack8(acc[ai][0][m][0] * rs, acc[ai][0][m][1] * rs);
                    *(u32x4*)(o1 + (size_t)row * 1024 + u.pn * 128 + cb) = pack8(acc[ai][1][m][0] * rs, acc[ai][1][m][1] * rs);
                } else if (MODE == EM_DQ) {
                    float s = 0.f;
#pragma unroll
                    for (int bj = 0; bj < 2; ++bj) { const f32x4 v0 = acc[ai][bj][m][0] * rs, v1 = acc[ai][bj][m][1] * rs; s += sq4(v0) + sq4(v1);
                        *(u32x4*)(o0 + (size_t)row * 768 + u.pn * BM + bj * HALF + cb) = pack8(v0, v1); }
                    s += __shfl_xor(s, 16); s += __shfl_xor(s, 32);
                    if (fq == 0) unsafeAtomicAdd(ssq_out + row, s);
                } else if (MODE == EM_UQ) {
                    const float sc = rs * scale;
                    if (u.pn < 4) {
#pragma unroll
                        for (int bj = 0; bj < 2; ++bj)
                            *(u32x4*)(o0 + (size_t)row * 1024 + u.pn * BM + bj * HALF + cb) = pack8(acc[ai][bj][m][0] * sc, acc[ai][bj][m][1] * sc);
                    } else {
                        const int head = (u.pn - 4) * 4 + wc; const int pos = row & 2047; const float* rp = rope + ((size_t)pos * 32 + 8 * fq) * 2;
                        f32x4 y0a, y0b, y1a, y1b;
#pragma unroll
                        for (int e = 0; e < 4; ++e) {
                            { const float x1 = sc * acc[ai][0][m][0][e], x2 = sc * acc[ai][1][m][0][e], c = rp[2 * e], sn = rp[2 * e + 1]; y0a[e] = x1 * c - x2 * sn; y1a[e] = x2 * c + x1 * sn; }
                            { const float x1 = sc * acc[ai][0][m][1][e], x2 = sc * acc[ai][1][m][1][e], c = rp[8 + 2 * e], sn = rp[8 + 2 * e + 1]; y0b[e] = x1 * c - x2 * sn; y1b[e] = x2 * c + x1 * sn; }
                        }
                        *(u32x4*)(o1 + (size_t)row * 512 + head * 64 + 8 * fq) = pack8(y0a, y0b);
                        *(u32x4*)(o1 + (size_t)row * 512 + head * 64 + 32 + 8 * fq) = pack8(y1a, y1b);
                    }
                }
            }
    }
};

template <class Epi, class Sched, bool ALIGN_EPI = false, bool SP2 = false>
__device__ __forceinline__ void gemm_phase(PG8_LAS unsigned char* lds, const Gemm g, const Sched& S, const Epi& E) {
    int tid_ = threadIdx.x; asm volatile("" : "+v"(tid_));
    const int tid = tid_, wid = __builtin_amdgcn_readfirstlane(tid >> 6), lane = tid & 63, wr = wid >> 2, wc = wid & 3, fr = lane & 15, fq = lane >> 4;
    const int K = g.K, nt = K / BK;
    unsigned voffA[2], voffB[2];
#pragma unroll
    for (int i = 0; i < 2; ++i) { int R, C; stage_rc(tid * 16 + i * 8192, R, C); const int Rb = Epi::PERM ? ((R & ~31) + perm32(R & 31)) : R;
        voffA[i] = (unsigned)(R * K + C) * 2u; voffB[i] = (unsigned)(Rb * K + C) * 2u; }
    const size_t kstep = (size_t)(BK * 2);
    const size_t hstep = (size_t)HALF * K * 2;
    const size_t tstep = 2 * hstep;
    const unsigned ldsw = (unsigned)wid * 1024u;
    const int aoff = lds_byte(wr * 64 + fr, fq * 8), boff = lds_byte(wc * 32 + fr, fq * 8);
#define PG8_SA(b, h) (((b) * 2 + (h)) * HTB)
#define PG8_SB(b, h) ((4 + (b) * 2 + (h)) * HTB)
#define PG8_STAGE(bufoff, gbase, voff) do { _Pragma("unroll") for (int _i = 0; _i < 2; ++_i) \
        __builtin_amdgcn_global_load_lds((const unsigned*)((const char*)(gbase) + (voff)[_i]), (PG8_LAS unsigned*)(lds + (bufoff) + ldsw + _i * 8192), 16, 0, 0); } while (0)
#define PG8_LDA(dst, b, h) do { _Pragma("unroll") for (int m = 0; m < 4; ++m) _Pragma("unroll") for (int k = 0; k < 2; ++k) dst[m][k] = *(const PG8_LAS bf16x8*)(lds + PG8_SA(b, h) + aoff + m * 2048 + k * 1024); } while (0)
#define PG8_LDB(dst, b, h) do { _Pragma("unroll") for (int n = 0; n < 2; ++n) _Pragma("unroll") for (int k = 0; k < 2; ++k) dst[n][k] = *(const PG8_LAS bf16x8*)(lds + PG8_SB(b, h) + boff + n * 2048 + k * 1024); } while (0)
#define PG8_MMA(ai, bj, At, Bt) do { __builtin_amdgcn_s_setprio(1); _Pragma("unroll") for (int m = 0; m < 4; ++m) _Pragma("unroll") for (int n = 0; n < 2; ++n) _Pragma("unroll") for (int k = 0; k < 2; ++k) \
        acc[ai][bj][m][n] = __builtin_amdgcn_mfma_f32_16x16x32_bf16(Bt[n][k], At[m][k], acc[ai][bj][m][n], 0, 0, 0); __builtin_amdgcn_s_setprio(0); } while (0)
#define PG8_WAIT_V(n) asm volatile("s_waitcnt vmcnt(" #n ")" ::: "memory")
#define PG8_WAIT_L(n) asm volatile("s_waitcnt lgkmcnt(" #n ")" ::: "memory")
#define PG8_BAR __builtin_amdgcn_s_barrier()
#define PG8_SCHED __builtin_amdgcn_sched_barrier(0)
    Unit cur, nxt; int ui = 0;
    if (!S.next(0, cur)) return;
    f32x4 acc[2][2][4][2];
#pragma unroll
    for (int a = 0; a < 2; ++a)
#pragma unroll
        for (int b = 0; b < 2; ++b)
#pragma unroll
            for (int m = 0; m < 4; ++m)
#pragma unroll
                for (int n = 0; n < 2; ++n) acc[a][b][m][n] = (f32x4){0.f, 0.f, 0.f, 0.f};
    bf16x8 At[4][2], B0[2][2], B1[2][2];
    const char* cA = (const char*)g.A + (size_t)cur.pm * tstep; const char* cB = (const char*)g.Bt + (size_t)cur.pn * tstep;
    S.a_ready(cur);
    if constexpr (SP2) {
        PG8_STAGE(PG8_SB(0, 0), cB, voffB); PG8_STAGE(PG8_SB(0, 1), cB + hstep, voffB); PG8_STAGE(PG8_SA(0, 0), cA, voffA); PG8_STAGE(PG8_SA(0, 1), cA + hstep, voffA);
        if (wr == 1) PG8_BAR;
        PG8_WAIT_V(2); PG8_BAR;
        PG8_STAGE(PG8_SB(1, 0), cB + kstep, voffB); PG8_STAGE(PG8_SA(1, 0), cA + kstep, voffA); PG8_STAGE(PG8_SB(1, 1), cB + hstep + kstep, voffB);
        PG8_WAIT_V(6); PG8_BAR;
    } else {
        PG8_STAGE(PG8_SB(0, 0), cB, voffB); PG8_STAGE(PG8_SA(0, 0), cA, voffA); PG8_STAGE(PG8_SB(0, 1), cB + hstep, voffB); PG8_STAGE(PG8_SA(0, 1), cA + hstep, voffA);
        if (wr == 1) PG8_BAR;
        PG8_WAIT_V(4); PG8_BAR;
        PG8_STAGE(PG8_SB(1, 0), cB + kstep, voffB); PG8_STAGE(PG8_SA(1, 0), cA + kstep, voffA); PG8_STAGE(PG8_SB(1, 1), cB + hstep + kstep, voffB);
        PG8_WAIT_V(6); PG8_BAR;
    }
    for (;;) {
        const bool has_next = S.next(ui + 1, nxt);
        const char* nA = has_next ? (const char*)g.A + (size_t)nxt.pm * tstep : cA; const char* nB = has_next ? (const char*)g.Bt + (size_t)nxt.pn * tstep : cB;
        for (int t = 0; t < nt; t += 2) {
            const bool last = (t == nt - 2);
            const char* a1 = cA + (size_t)(t + 1) * kstep;
            const char* a2 = last ? nA : cA + (size_t)(t + 2) * kstep; const char* b2 = last ? nB : cB + (size_t)(t + 2) * kstep;
            const char* a3 = a2 + kstep; const char* b3 = b2 + kstep;
            if (last && has_next) S.a_ready(nxt);
            if constexpr (SP2) {
            PG8_LDB(B0, 0, 0); PG8_LDB(B1, 0, 1); PG8_SCHED; PG8_LDA(At, 0, 0); PG8_STAGE(PG8_SA(1, 1), a1 + hstep, voffA);
            PG8_WAIT_V(8); PG8_WAIT_L(0); PG8_BAR; PG8_MMA(0, 0, At, B0); PG8_MMA(0, 1, At, B1); PG8_BAR; PG8_SCHED;
            PG8_LDA(At, 0, 1); PG8_STAGE(PG8_SB(0, 0), b2, voffB); PG8_STAGE(PG8_SB(0, 1), b2 + hstep, voffB); PG8_STAGE(PG8_SA(0, 0), a2, voffA);
            PG8_WAIT_V(8); PG8_WAIT_L(0); PG8_BAR; PG8_MMA(1, 0, At, B0); PG8_MMA(1, 1, At, B1); PG8_BAR; PG8_SCHED;
            PG8_LDB(B0, 1, 0); PG8_LDB(B1, 1, 1); PG8_SCHED; PG8_LDA(At, 1, 0); PG8_STAGE(PG8_SA(0, 1), a2 + hstep, voffA);
            PG8_WAIT_V(8); PG8_WAIT_L(0); PG8_BAR; PG8_MMA(0, 0, At, B0); PG8_MMA(0, 1, At, B1); PG8_BAR; PG8_SCHED;
            PG8_LDA(At, 1, 1); PG8_STAGE(PG8_SB(1, 0), b3, voffB); PG8_STAGE(PG8_SB(1, 1), b3 + hstep, voffB); PG8_STAGE(PG8_SA(1, 0), a3, voffA);
            PG8_WAIT_V(8); PG8_WAIT_L(0); PG8_BAR; PG8_MMA(1, 0, At, B0); PG8_MMA(1, 1, At, B1); PG8_BAR; PG8_SCHED;
            } else {
            PG8_LDB(B0, 0, 0); PG8_SCHED; PG8_LDA(At, 0, 0); PG8_STAGE(PG8_SA(1, 1), a1 + hstep, voffA);
            PG8_WAIT_L(8); PG8_BAR; PG8_WAIT_L(0); PG8_MMA(0, 0, At, B0); PG8_BAR; PG8_SCHED;
            PG8_LDB(B1, 0, 1); PG8_STAGE(PG8_SB(0, 0), b2, voffB);
            PG8_BAR; PG8_WAIT_L(0); PG8_MMA(0, 1, At, B1); PG8_BAR;
            PG8_LDA(At, 0, 1); PG8_STAGE(PG8_SA(0, 0), a2, voffA);
            PG8_BAR; PG8_WAIT_L(0); PG8_MMA(1, 0, At, B0); PG8_BAR; PG8_SCHED;
            PG8_STAGE(PG8_SB(0, 1), b2 + hstep, voffB);
            PG8_WAIT_V(6); PG8_BAR; PG8_MMA(1, 1, At, B1); PG8_BAR;
            PG8_LDB(B0, 1, 0); PG8_SCHED; PG8_LDA(At, 1, 0); PG8_STAGE(PG8_SA(0, 1), a2 + hstep, voffA);
            PG8_WAIT_L(8); PG8_BAR; PG8_WAIT_L(0); PG8_MMA(0, 0, At, B0); PG8_BAR; PG8_SCHED;
            PG8_LDB(B1, 1, 1); PG8_STAGE(PG8_SB(1, 0), b3, voffB);
            PG8_BAR; PG8_WAIT_L(0); PG8_MMA(0, 1, At, B1); PG8_BAR;
            PG8_LDA(At, 1, 1); PG8_STAGE(PG8_SA(1, 0), a3, voffA);
            PG8_BAR; PG8_WAIT_L(0); PG8_MMA(1, 0, At, B0); PG8_BAR; PG8_SCHED;
            PG8_STAGE(PG8_SB(1, 1), b3 + hstep, voffB);
            PG8_WAIT_V(6); PG8_BAR; PG8_MMA(1, 1, At, B1); PG8_BAR;
            }
        }
        if constexpr (ALIGN_EPI) { if (wr == 0) PG8_BAR; }
        if constexpr (!Epi::AFTER_DRAIN) { E(acc, cur, wr, wc, fr, fq); S.done(cur); }
        if (!has_next) break;
#pragma unroll
        for (int a = 0; a < 2; ++a)
#pragma unroll
            for (int b = 0; b < 2; ++b)
#pragma unroll
                for (int m = 0; m < 4; ++m)
#pragma unroll
                    for (int n = 0; n < 2; ++n) acc[a][b][m][n] = (f32x4){0.f, 0.f, 0.f, 0.f};
        cur = nxt; cA = nA; cB = nB; ++ui;
        if constexpr (ALIGN_EPI) { if (wr == 1) PG8_BAR; }
    }
    PG8_WAIT_V(0);
    if constexpr (!ALIGN_EPI) { if (wr == 0) PG8_BAR; }
    PG8_BAR;
    if constexpr (Epi::AFTER_DRAIN) { E.fused(acc, cur, wr, wc, fr, fq, lds, wid, lane); S.done(cur); }
#undef PG8_SA
#undef PG8_SB
#undef PG8_STAGE
#undef PG8_LDA
#undef PG8_LDB
#undef PG8_MMA
#undef PG8_WAIT_V
#undef PG8_WAIT_L
#undef PG8_BAR
#undef PG8_SCHED
}
}

#include <hip/hip_cooperative_groups.h>
#include <cstdio>
#include <cstdint>
namespace cg = cooperative_groups;
#define LAS __attribute__((address_space(3)))
typedef unsigned short bf16;
typedef float f32x4 __attribute__((ext_vector_type(4)));
typedef float f32x16 __attribute__((ext_vector_type(16)));
typedef short bf16x8 __attribute__((ext_vector_type(8)));
typedef unsigned u32x4 __attribute__((ext_vector_type(4)));
typedef unsigned u32x2 __attribute__((ext_vector_type(2)));
typedef short s16x4 __attribute__((ext_vector_type(4)));

constexpr int NWAVES = 8, NTHREADS = 512;
constexpr int BATCH = 16, SEQ = 2048, D = 1024, M = BATCH * SEQ, FF = 2816;
constexpr int LDS_BYTES = 131072 + 256, MISC_OFF = 131072;
constexpr size_t MiB = 1u << 20;
constexpr size_t WS_SSQ = 0;
constexpr size_t WS_ROPE = 2 * MiB;
constexpr size_t WS_CTL = 3 * MiB, CTL_BYTES = 16384;
constexpr size_t WS_W = 4 * MiB;
constexpr size_t W_FFIN = (size_t)5632 * 1024 * 2, W_FFOUT = (size_t)1024 * 2816 * 2;
constexpr size_t WO_FFIN0 = 0, WO_FFOUT0 = WO_FFIN0 + 4 * W_FFIN;
constexpr size_t WO_QKV = WO_FFOUT0 + 4 * W_FFOUT, WO_AWO = WO_QKV + (size_t)3072 * 1024 * 2, WO_KVD = WO_AWO + (size_t)1024 * 1024 * 2;
constexpr size_t WO_KVU = WO_KVD + (size_t)512 * 1024 * 2, WO_DQ = WO_KVU + (size_t)2048 * 256 * 2, WO_UQ = WO_DQ + (size_t)768 * 1024 * 2;
constexpr size_t WO_BWO = WO_UQ + (size_t)1536 * 768 * 2, WO_END = WO_BWO + (size_t)1024 * 1024 * 2;
static_assert(WO_END <= 96 * MiB, "weights fit");
constexpr size_t WS_HB = 100 * MiB;
constexpr size_t WS_BIG = 164 * MiB;
constexpr size_t WS_ACT = WS_BIG, WS_Q = WS_BIG, WS_K = WS_BIG + 64 * MiB, WS_V = WS_BIG + 128 * MiB;
constexpr size_t WS_QN = WS_BIG, WS_QR = WS_BIG + 64 * MiB, WS_CQ = WS_BIG + 96 * MiB;
constexpr size_t WS_KN = 356 * MiB, WS_VB = WS_KN + 64 * MiB, WS_CKV = WS_VB + 64 * MiB, WS_KR = WS_CKV + 16 * MiB, WS_END = WS_KR + 4 * MiB;
static_assert(WS_END <= 512 * MiB, "ws map");

__device__ __forceinline__ unsigned f2bf(float f) { unsigned u = __builtin_bit_cast(unsigned, f); return (u + 0x7fffu + ((u >> 16) & 1u)) >> 16; }
__device__ __forceinline__ unsigned pk2(float lo, float hi) { return f2bf(lo) | (f2bf(hi) << 16); }
__device__ __forceinline__ float wave_sum(float v) {
#pragma unroll
    for (int o = 1; o < 64; o <<= 1) v += __shfl_xor(v, o);
    return v;
}

enum { MAP_ID = 0, MAP_SWIGLU = 1, MAP_KVDOWN = 2, MAP_UQ = 3 };
template <int MAP> __device__ __forceinline__ int map_col(int np) {
    if (MAP == MAP_ID) return np;
    if (MAP == MAP_SWIGLU) { const int t = np >> 8, rem = np & 255, half = rem >> 7, c = rem & 127; return half * 2816 + 128 * t + c; }
    if (MAP == MAP_KVDOWN) { if (np < 256) return np; const int rem = np - 256, half = rem >> 7, c = rem & 127; return c < 32 ? 256 + 32 * half + c : -1; }
    if (np < 1024) { const int t = np >> 8, bj = (np >> 7) & 1, c = np & 127; return (2 * t + bj) * 192 + c; }
    { const int rem = np - 1024, t = rem >> 8, half = (rem >> 7) & 1, c = rem & 127, head = t * 4 + (c >> 5); return head * 192 + 128 + 32 * half + (c & 31); }
}
template <int MAP> __device__ __forceinline__ void conv_item(const float* W, int K, int Nsrc, int NP, bf16* WT, const float* gain, int item, int lane) {
    const int nblk = NP / 128, kb0 = item / nblk, nb = item % nblk, k0 = 64 * kb0, n0 = 128 * nb;
    const int nq = lane & 31, kh = lane >> 5;
    const int s32 = map_col<MAP>(n0 + ((4 * nq) & ~31));
    const int src = s32 + ((4 * nq) & 31);
    bf16* dst = WT + (size_t)(n0 + 4 * nq) * K + k0 + 8 * kh;
    if (s32 < 0) {
#pragma unroll
        for (int kk = 0; kk < 4; ++kk)
#pragma unroll
            for (int c = 0; c < 4; ++c) *(u32x4*)(dst + (size_t)c * K + 16 * kk) = (u32x4){0u, 0u, 0u, 0u};
        return;
    }
#pragma unroll
    for (int kp = 0; kp < 2; ++kp) {
        f32x4 v[2][8]; f32x4 g0[2], g1[2];
#pragma unroll
        for (int k2 = 0; k2 < 2; ++k2) { const int kb = k0 + 16 * (2 * kp + k2) + 8 * kh;
#pragma unroll
            for (int j = 0; j < 8; ++j) v[k2][j] = __builtin_nontemporal_load((const f32x4*)(W + (size_t)(kb + j) * Nsrc + src));
            if (gain) { g0[k2] = *(const f32x4*)(gain + kb); g1[k2] = *(const f32x4*)(gain + kb + 4); } else { g0[k2] = (f32x4){1.f, 1.f, 1.f, 1.f}; g1[k2] = g0[k2]; } }
#pragma unroll
        for (int k2 = 0; k2 < 2; ++k2)
#pragma unroll
            for (int c = 0; c < 4; ++c) { u32x4 o;
                o.x = pk2(v[k2][0][c] * g0[k2][0], v[k2][1][c] * g0[k2][1]); o.y = pk2(v[k2][2][c] * g0[k2][2], v[k2][3][c] * g0[k2][3]);
                o.z = pk2(v[k2][4][c] * g1[k2][0], v[k2][5][c] * g1[k2][1]); o.w = pk2(v[k2][6][c] * g1[k2][2], v[k2][7][c] * g1[k2][3]);
                *(u32x4*)(dst + (size_t)c * K + 16 * (2 * kp + k2)) = o; }
    }
}

struct Args {
    const float* in[20]; float* out; unsigned char* ws; int ph_lo, ph_hi, use_cg, pad;
};

template <int MLA> __device__ __forceinline__ void attn_phase(LAS unsigned char* lds, int G, int cwg,
        const bf16* Q0, const bf16* Q1, const bf16* K0, const bf16* K1, const bf16* V, bf16* O, const float* rel_table) {
    constexpr int DQK = MLA ? 192 : 64, DV = MLA ? 128 : 64, NH = MLA ? 8 : 16, NKS = DQK / 16, NDB = DV / 32;
    constexpr int KROW = DQK + 8, VROW = DV + 32;
    constexpr int KCH = DQK / 8, NKC = 64 * KCH / NTHREADS;
    constexpr int NVC = 64 * (DV / 8) / NTHREADS;
    LAS bf16* Ks = (LAS bf16*)lds;
    LAS bf16* Vt = (LAS bf16*)(lds + 64 * KROW * 2);
    LAS float* Bt = (LAS float*)(lds + 64 * KROW * 2 + 64 * VROW * 2);
    int tid_ = threadIdx.x; asm volatile("" : "+v"(tid_));
    const int tid = tid_, lane = tid & 63, wid = __builtin_amdgcn_readfirstlane(tid >> 6), r32 = lane & 31, hi = lane >> 5;
    const int nunits = BATCH * NH * 8;
    const int pi = 16 * (r32 >> 4) + 8 * ((r32 >> 2) & 1) + 4 * ((r32 >> 3) & 1) + (r32 & 3);
    for (int L = cwg; L < nunits; L += G) {
        int b, h, grp;
        if (MLA) { const int pair = L / (BATCH * NH), bh = L % (BATCH * NH); b = bh / NH; h = bh % NH; grp = (0x10235467 >> (4 * pair)) & 7; }
        else { grp = L / (BATCH * NH); const int bh = L % (BATCH * NH); b = bh / NH; h = bh % NH; }
        const int tok0 = b * SEQ;
        const int cq = 4 * grp + (wid >> 1);
        const int qrow = tok0 + 256 * grp + 32 * wid + r32;
        const int kc_lo = MLA ? 0 : ((4 * grp - 8) > 0 ? (4 * grp - 8) : 0), kc_hi = 4 * grp + 3;
        bf16x8 qf[NKS];
#pragma unroll
        for (int ks = 0; ks < NKS; ++ks) {
            const bf16* src;
            if (!MLA) src = Q0 + (size_t)qrow * 1024 + h * 64 + 16 * ks + 8 * hi;
            else src = (ks < 8) ? Q0 + (size_t)qrow * 1024 + h * 128 + 16 * ks + 8 * hi : Q1 + (size_t)qrow * 512 + h * 64 + 16 * (ks - 8) + 8 * hi;
            qf[ks] = *(const bf16x8*)src;
        }
        if (!MLA) { __syncthreads(); for (int i = tid; i < 257; i += NTHREADS) Bt[i] = rel_table[h * 257 + i] * 1.4426950408889634f; }
        f32x16 o[NDB];
#pragma unroll
        for (int db = 0; db < NDB; ++db)
#pragma unroll
            for (int r = 0; r < 16; ++r) o[db][r] = 0.f;
        float mrun = -1e30f, lrun = 0.f;
        u32x4 kreg[NKC], vreg[NVC];
        auto prefetch = [&](int kc) {
            const int t0 = tok0 + 64 * kc;
#pragma unroll
            for (int j = 0; j < NKC; ++j) { const int c = tid + NTHREADS * j, row = c / KCH, ch = c % KCH; const bf16* src;
                if (!MLA) src = K0 + (size_t)(t0 + row) * 1024 + h * 64 + ch * 8;
                else src = (ch < 16) ? K0 + (size_t)(t0 + row) * 1024 + h * 128 + ch * 8 : K1 + (size_t)(t0 + row) * 64 + (ch - 16) * 8;
                kreg[j] = *(const u32x4*)src; }
#pragma unroll
            for (int j = 0; j < NVC; ++j) { const int c = tid + NTHREADS * j, kv = c / (DV / 8), dch = c % (DV / 8);
                vreg[j] = *(const u32x4*)(V + (size_t)(t0 + kv) * 1024 + h * DV + dch * 8); }
        };
        prefetch(kc_lo);
        for (int kc = kc_lo; kc <= kc_hi; ++kc) {
            __syncthreads();
#pragma unroll
            for (int j = 0; j < NKC; ++j) { const int c = tid + NTHREADS * j, row = c / KCH, ch = c % KCH; *(LAS u32x4*)(Ks + row * KROW + ch * 8) = kreg[j]; }
#pragma unroll
            for (int j = 0; j < NVC; ++j) { const int c = tid + NTHREADS * j, kv = c / (DV / 8), dch = c % (DV / 8); *(LAS u32x4*)(Vt + kv * VROW + dch * 8) = vreg[j]; }
            __syncthreads();
            if (kc < kc_hi) prefetch(kc + 1);
            const bool active = MLA ? (kc <= cq) : (kc <= cq && kc >= cq - 8);
            if (active) {
                f32x16 st[2];
#pragma unroll
                for (int p = 0; p < 2; ++p)
#pragma unroll
                    for (int r = 0; r < 16; ++r) st[p][r] = 0.f;
                {
                    constexpr int NF = 2 * NKS, KLA = MLA ? 4 : 6;
                    bf16x8 kf[NF];
#define KREAD(f) kf[f] = *(const LAS bf16x8*)(Ks + (32 * ((f) & 1) + pi) * KROW + 16 * ((f) >> 1) + 8 * hi)
#pragma unroll
                    for (int f = 0; f < KLA; ++f) KREAD(f);
                    __builtin_amdgcn_sched_barrier(0);
#pragma unroll
                    for (int g = 0; g < NKS; ++g) {
                        st[0] = __builtin_amdgcn_mfma_f32_32x32x16_bf16(kf[2 * g], qf[g], st[0], 0, 0, 0);
                        st[1] = __builtin_amdgcn_mfma_f32_32x32x16_bf16(kf[2 * g + 1], qf[g], st[1], 0, 0, 0);
                        if (2 * g + KLA < NF) KREAD(2 * g + KLA);
                        if (2 * g + KLA + 1 < NF) KREAD(2 * g + KLA + 1);
                        __builtin_amdgcn_sched_barrier(0);
                    }
#undef KREAD
                }
                if (!MLA) {
                    if (cq - kc >= 3) {
                        const float cbias = Bt[256];
#pragma unroll
                        for (int p = 0; p < 2; ++p)
#pragma unroll
                            for (int r = 0; r < 16; ++r) st[p][r] += cbias;
                    } else {
                        const int base = 64 * (cq - kc) + 32 * (wid & 1) + r32 - 8 * hi + 128;
#pragma unroll
                        for (int p = 0; p < 2; ++p)
#pragma unroll
                            for (int r = 0; r < 16; ++r) { int idx = base - (32 * p + 16 * (r >> 3) + (r & 7)); idx = idx > 256 ? 256 : idx; st[p][r] += Bt[idx]; }
                    }
                }
                float mx = st[0][0];
#pragma unroll
                for (int p = 0; p < 2; ++p)
#pragma unroll
                    for (int r = 0; r < 16; ++r) mx = fmaxf(mx, st[p][r]);
                mx = fmaxf(mx, __shfl_xor(mx, 32));
                const float mnew = fmaxf(mrun, mx), alpha = __builtin_amdgcn_exp2f(mrun - mnew);
                mrun = mnew;
                float rsum = 0.f;
#pragma unroll
                for (int p = 0; p < 2; ++p)
#pragma unroll
                    for (int r = 0; r < 16; ++r) { st[p][r] = __builtin_amdgcn_exp2f(st[p][r] - mnew); rsum += st[p][r]; }
                lrun = lrun * alpha + rsum;
                if (__any(alpha != 1.0f)) {
#pragma unroll
                for (int db = 0; db < NDB; ++db)
#pragma unroll
                    for (int r = 0; r < 16; ++r) o[db][r] *= alpha;
                }
                bf16x8 pf[2][2];
#pragma unroll
                for (int p = 0; p < 2; ++p)
#pragma unroll
                    for (int s = 0; s < 2; ++s) { u32x4 w; w.x = pg8::cvt_pk_bf16(st[p][8 * s + 0], st[p][8 * s + 1]); w.y = pg8::cvt_pk_bf16(st[p][8 * s + 2], st[p][8 * s + 3]);
                        w.z = pg8::cvt_pk_bf16(st[p][8 * s + 4], st[p][8 * s + 5]); w.w = pg8::cvt_pk_bf16(st[p][8 * s + 6], st[p][8 * s + 7]); pf[p][s] = __builtin_bit_cast(bf16x8, w); }
                {
                    constexpr int NFV = 4 * NDB, VLA = MLA ? 2 : 4;
                    bf16x8 vf[NFV];
                    const LAS bf16* vbase = Vt + (8 * hi + ((lane & 15) >> 2)) * VROW + 16 * ((lane >> 4) & 1) + 4 * (lane & 3);
#define VREAD(f) do { const LAS bf16* vp_ = vbase + (32 * (((f) / NDB) >> 1) + 16 * (((f) / NDB) & 1)) * VROW + 32 * ((f) % NDB); \
                        const s16x4 vlo_ = __builtin_bit_cast(s16x4, __builtin_amdgcn_ds_read_tr16_b64_v4i16((LAS s16x4*)vp_)); \
                        const s16x4 vhi_ = __builtin_bit_cast(s16x4, __builtin_amdgcn_ds_read_tr16_b64_v4i16((LAS s16x4*)(vp_ + 4 * VROW))); \
                        vf[f] = __builtin_shufflevector(vlo_, vhi_, 0, 1, 2, 3, 4, 5, 6, 7); } while (0)
#pragma unroll
                    for (int f = 0; f < VLA; ++f) VREAD(f);
                    __builtin_amdgcn_sched_barrier(0);
#pragma unroll
                    for (int f = 0; f < NFV; ++f) {
                        o[f % NDB] = __builtin_amdgcn_mfma_f32_32x32x16_bf16(vf[f], pf[(f / NDB) >> 1][(f / NDB) & 1], o[f % NDB], 0, 0, 0);
                        if (f + VLA < NFV) VREAD(f + VLA);
                        __builtin_amdgcn_sched_barrier(0);
                    }
#undef VREAD
                }
            }
        }
        const float ltot = lrun + __shfl_xor(lrun, 32), rl = 1.0f / ltot;
        bf16* orow = O + (size_t)qrow * 1024 + h * DV;
#pragma unroll
        for (int db = 0; db < NDB; ++db)
#pragma unroll
            for (int j = 0; j < 2; ++j) {
                const unsigned ax = pg8::cvt_pk_bf16(o[db][8 * j] * rl, o[db][8 * j + 1] * rl), ay = pg8::cvt_pk_bf16(o[db][8 * j + 2] * rl, o[db][8 * j + 3] * rl);
                const unsigned bx = pg8::cvt_pk_bf16(o[db][8 * j + 4] * rl, o[db][8 * j + 5] * rl), by = pg8::cvt_pk_bf16(o[db][8 * j + 6] * rl, o[db][8 * j + 7] * rl);
                const auto sx = __builtin_amdgcn_permlane32_swap(ax, bx, false, false); const auto sy = __builtin_amdgcn_permlane32_swap(ay, by, false, false);
                u32x4 w; w.x = sx[0]; w.y = sy[0]; w.z = sx[1]; w.w = sy[1];
                *(u32x4*)(orow + 32 * db + 16 * j + 8 * hi) = w; }
        __syncthreads();
    }
}

#define RLX_AGENT __ATOMIC_RELAXED, __HIP_MEMORY_SCOPE_AGENT
#define XB_TMO      128
#define XB_XCNT(j)  (256  + 64 * (j))
#define XB_XSUB(j)  (1280 + 64 * (j))
#define XB_XGEN(j)  (2304 + 64 * (j))
#define XB_TOP      3328
#define XB_TOPGEN   3392
#define XCD_BAR_WORDS 3456
#define XB_SPIN_CAP (1u << 18)

__device__ __forceinline__ unsigned xb_ld(unsigned* p)              { return __hip_atomic_load(p, __ATOMIC_RELAXED, __HIP_MEMORY_SCOPE_AGENT); }
__device__ __forceinline__ unsigned xb_add(unsigned* p, unsigned v) { return __hip_atomic_fetch_add(p, v, __ATOMIC_RELAXED, __HIP_MEMORY_SCOPE_AGENT); }
__device__ __forceinline__ unsigned xb_xcc_id() { return (unsigned)__builtin_amdgcn_s_getreg((3 << 11) | 20) & 0xFu; }
#define XB_SPIN(cond, bar) do { unsigned _sp = 0; while (cond) { __builtin_amdgcn_s_sleep(1); \
    if ((++_sp & 255u) == 0u) { if (xb_ld(&(bar)[XB_TMO])) break; if (_sp > XB_SPIN_CAP) { atomicAdd(&(bar)[XB_TMO], 1u); break; } } } } while (0)

struct XcdBarrier {
    unsigned* bar; unsigned x;
    volatile LAS unsigned* st;
};

__device__ __forceinline__ XcdBarrier xcd_barrier_post(unsigned* bar, volatile LAS unsigned* st) {
    XcdBarrier b; b.bar = bar; b.x = xb_xcc_id(); b.st = st;
    if (threadIdx.x == 0) (void)xb_add(&bar[XB_XCNT(b.x)], 1u);
    return b;
}
__device__ __forceinline__ void xcd_barrier_complete(unsigned* bar, unsigned x, unsigned& nloc, unsigned& nx) {
    const unsigned G = gridDim.x * gridDim.y * gridDim.z;
    unsigned sum, cnt, mine, sp = 0u;
    for (;;) {
        sum = 0u; cnt = 0u; mine = 0u;
#pragma unroll
        for (unsigned j = 0; j < 16; ++j) { const unsigned c = xb_ld(&bar[XB_XCNT(j)]); sum += c; cnt += (c > 0u) ? 1u : 0u; mine = (j == x) ? c : mine; }
        if (sum == G) break;
        __builtin_amdgcn_s_sleep(1);
        if ((++sp & 255u) == 0u) { if (xb_ld(&bar[XB_TMO])) break; if (sp > XB_SPIN_CAP) { atomicAdd(&bar[XB_TMO], 1u); break; } }
    }
    nloc = mine > 0u ? mine : 1u; nx = cnt > 0u ? cnt : 1u;
}

__device__ __forceinline__ void xcd_barrier(const XcdBarrier& b) {
    asm volatile("s_waitcnt vmcnt(0)" ::: "memory");
    __syncthreads();
    if (threadIdx.x == 0) {
        unsigned* bar = b.bar;
        __builtin_amdgcn_s_waitcnt(0);
        unsigned nloc = b.st[0], nx = b.st[1];
        if (nloc == 0u) { xcd_barrier_complete(bar, b.x, nloc, nx); b.st[0] = nloc; b.st[1] = nx; }
        const unsigned old = xb_add(&bar[XB_XSUB(b.x)], 1u);
        const unsigned gen = old / nloc;
        if (old + 1u == (gen + 1u) * nloc) {
            __builtin_amdgcn_fence(__ATOMIC_RELEASE, "agent");
            asm volatile("s_waitcnt vmcnt(0)" ::: "memory");
            const unsigned og = xb_add(&bar[XB_TOP], 1u);
            const unsigned tg = og / nx;
            if (og + 1u == (tg + 1u) * nx) xb_add(&bar[XB_TOPGEN], 1u);
            else XB_SPIN(xb_ld(&bar[XB_TOPGEN]) == tg, bar);
            __builtin_amdgcn_fence(__ATOMIC_ACQUIRE, "agent");
            xb_add(&bar[XB_XGEN(b.x)], 1u);
            asm volatile("s_waitcnt vmcnt(0)" ::: "memory");
        } else {
            XB_SPIN(xb_ld(&bar[XB_XGEN(b.x)]) == gen, bar);
            __builtin_amdgcn_fence(__ATOMIC_ACQUIRE, "agent");
            asm volatile("s_waitcnt vmcnt(0)" ::: "memory");
        }
    }
    __syncthreads();
}

__device__ __forceinline__ const void* karg_ptr(int i) {
    const __attribute__((address_space(4))) char* kp = (const __attribute__((address_space(4))) char*)__builtin_amdgcn_kernarg_segment_ptr();
    asm volatile("" : "+s"(kp));
    return *(const void* const __attribute__((address_space(4)))*)(kp + 8 * i);
}
#define KARG(i) ((const float*)karg_ptr(i))
#define WSP ((unsigned char*)karg_ptr(21))
#define HRES ((float*)karg_ptr(20))
#define SSQ ((float*)(WSP + WS_SSQ))
#define ROPE ((float*)(WSP + WS_ROPE))
#define WPTR(off) ((bf16*)(WSP + WS_W + (off)))
#define BPTR(off) ((bf16*)(WSP + (off)))
template <int PASS> __device__ __forceinline__ void convert_weights(int lane, int gw, int NGW) {
        constexpr int I_FFIN = 16 * 44, I_FFOUT = 44 * 8, I_QKV = 16 * 24, I_WO = 16 * 8, I_KVD = 16 * 4, I_KVU = 4 * 16, I_DQ = 16 * 6, I_UQ = 12 * 12;
        constexpr int NFM = PASS == 0 ? 1 : 3, W0 = PASS == 0 ? 0 : 1;
        constexpr int NITEMS = PASS == 0 ? (I_FFIN + I_FFOUT + I_QKV) : (3 * I_FFIN + 3 * I_FFOUT + 2 * I_WO + I_KVD + I_KVU + I_DQ + I_UQ);
        for (int it = gw; it < NITEMS; it += NGW) {
            int r = it;
            if (r < NFM * I_FFIN) { const int w = W0 + r / I_FFIN, layer = w >> 1, which = w & 1; r -= (w - W0) * I_FFIN;
                conv_item<MAP_SWIGLU>((which ? KARG(6) : KARG(2)) + (size_t)layer * 1024 * 5632, 1024, 5632, 5632, WPTR(WO_FFIN0) + (size_t)w * (W_FFIN / 2), (which ? KARG(5) : KARG(1)) + layer * 1024, r, lane); continue; }
            r -= NFM * I_FFIN;
            if (r < NFM * I_FFOUT) { const int w = W0 + r / I_FFOUT, layer = w >> 1, which = w & 1; r -= (w - W0) * I_FFOUT;
                conv_item<MAP_ID>((which ? KARG(7) : KARG(3)) + (size_t)layer * 2816 * 1024, 2816, 1024, 1024, WPTR(WO_FFOUT0) + (size_t)w * (W_FFOUT / 2), nullptr, r, lane); continue; }
            r -= NFM * I_FFOUT;
            if (PASS == 0) {
                conv_item<MAP_ID>(KARG(8), 1024, 3072, 3072, WPTR(WO_QKV), KARG(4), r, lane);
            } else {
                if (r < I_WO) { conv_item<MAP_ID>(KARG(10), 1024, 1024, 1024, WPTR(WO_AWO), nullptr, r, lane); continue; } r -= I_WO;
                if (r < I_WO) { conv_item<MAP_ID>(KARG(18), 1024, 1024, 1024, WPTR(WO_BWO), nullptr, r, lane); continue; } r -= I_WO;
                if (r < I_KVD) { conv_item<MAP_KVDOWN>(KARG(12), 1024, 320, 512, WPTR(WO_KVD), KARG(11), r, lane); continue; } r -= I_KVD;
                if (r < I_KVU) { conv_item<MAP_ID>(KARG(14), 256, 2048, 2048, WPTR(WO_KVU), KARG(13), r, lane); continue; } r -= I_KVU;
                if (r < I_DQ) { conv_item<MAP_ID>(KARG(15), 1024, 768, 768, WPTR(WO_DQ), KARG(4) + 1024, r, lane); continue; } r -= I_DQ;
                conv_item<MAP_UQ>(KARG(17), 768, 1536, 1536, WPTR(WO_UQ), KARG(16), r, lane);
            }
        }
}
__device__ __forceinline__ void prologue_phase(LAS unsigned char* lds, int tid, int lane, int wave, int G, int bx, int gw, int NGW) {
        convert_weights<0>(lane, gw, NGW);
        { const float* x = KARG(0); bf16* hb = BPTR(WS_HB); float* ssq = SSQ; float* rope = ROPE;
        for (int m = gw; m < M; m += NGW) {
            const f32x4* xr = (const f32x4*)(x + (size_t)m * D) + lane; f32x4 v[4]; float s = 0.f;
#pragma unroll
            for (int j = 0; j < 4; ++j) { v[j] = __builtin_nontemporal_load(xr + 64 * j); s += pg8::sq4(v[j]); }
            s = wave_sum(s);
            u32x2* o8 = (u32x2*)(hb + (size_t)m * D) + lane;
#pragma unroll
            for (int j = 0; j < 4; ++j) { u32x2 w; w.x = pk2(v[j][0], v[j][1]); w.y = pk2(v[j][2], v[j][3]); o8[64 * j] = w; }
            if (lane == 0) ssq[m] = s;
        }
        for (int i = bx * NTHREADS + tid; i < 8 * M; i += G * NTHREADS) ssq[M + i] = 0.f;
        for (int i = bx * NTHREADS + tid; i < 2048 * 32; i += G * NTHREADS) { const int pos = i >> 5, j = i & 31;
            const float freq = powf(10000.0f, -(float)j / 32.0f); const float ang = (float)pos * freq; rope[2 * i] = cosf(ang); rope[2 * i + 1] = sinf(ang); }
        }
        __syncthreads();
    }
#ifndef PROBE_PRO
#define PROBE_PRO
#endif
__global__ void __launch_bounds__(NTHREADS, 2) yoco_fwd(Args args) {
    extern __shared__ __attribute__((aligned(16))) unsigned char lds_raw[];
    LAS unsigned char* lds = (LAS unsigned char*)lds_raw;
    cg::grid_group grid = cg::this_grid();
    const int tid = threadIdx.x, lane = tid & 63, wave = __builtin_amdgcn_readfirstlane(tid >> 6);
    const int G = gridDim.x, bx = blockIdx.x;
    for (int u = tid; u < 64; u += NTHREADS) ((LAS unsigned*)(lds + MISC_OFF))[u] = 0u;
    __syncthreads();
    XcdBarrier bar = xcd_barrier_post((unsigned*)((unsigned char*)karg_ptr(21) + WS_CTL), (volatile LAS unsigned*)(lds + MISC_OFF));
    const int gw = bx * NWAVES + wave, NGW = G * NWAVES;
    const int lo = args.ph_lo, hi = args.ph_hi, use_cg = args.use_cg;
#define IN(k) (lo <= (k) && (k) < hi)
#define SEAM(k) do { if (IN(k) && IN((k) + 1)) { if (use_cg) grid.sync(); else xcd_barrier(bar); } } while (0)
    constexpr float C2A = 0.125f * 1.4426950408889634f;
    constexpr float C2B = 0.07216878364870322f * 1.4426950408889634f;

    if (IN(0)) { prologue_phase(lds, tid, lane, wave, G, bx, gw, NGW); PROBE_PRO }
    SEAM(0);
#define GEMM_PHASE(MODE, Aptr, Bptr, NN, KK, EPI) do { pg8::Gemm g_{Aptr, Bptr, M, NN, KK}; pg8::StaticOrder S_; S_.init(M, NN, G, bx); \
        pg8::gemm_phase<pg8::Epi<MODE>, pg8::StaticOrder, true, true>(lds, g_, S_, EPI); } while (0)
#define FFN_IN(kssq, widx) do { pg8::Epi<pg8::EM_SWIGLU> E{SSQ + (size_t)(kssq) * M, i1024, BPTR(WS_ACT), nullptr, nullptr, nullptr, nullptr, nullptr, 1.f, nullptr}; \
        GEMM_PHASE(pg8::EM_SWIGLU, BPTR(WS_HB), WPTR(WO_FFIN0 + (widx) * W_FFIN), 5632, 1024, E); } while (0)
#define FFN_OUT(MODE, HOLD, kssq, widx) do { pg8::Epi<MODE> E{nullptr, 0.f, BPTR(WS_HB), nullptr, nullptr, HOLD, HRES, SSQ + (size_t)(kssq) * M, 0.5f, nullptr}; \
        GEMM_PHASE(MODE, BPTR(WS_ACT), WPTR(WO_FFOUT0 + (widx) * W_FFOUT), 1024, 2816, E); } while (0)
#define WO_PROJ(Aoff, Woff, kssq) do { pg8::Epi<pg8::EM_RES> E{nullptr, 0.f, BPTR(WS_HB), nullptr, nullptr, nullptr, nullptr, SSQ + (size_t)(kssq) * M, 1.0f, nullptr}; \
        GEMM_PHASE(pg8::EM_RES, BPTR(Aoff), WPTR(Woff), 1024, 1024, E); } while (0)
    const float i1024 = 1.0f / 1024.0f;
    if (IN(1)) FFN_IN(0, 0);
    SEAM(1);
    if (IN(2)) FFN_OUT(pg8::EM_RES, nullptr, 1, 0);
    SEAM(2);
    if (IN(3)) { pg8::Epi<pg8::EM_QKV> E{SSQ + 1 * M, i1024, BPTR(WS_Q), nullptr, nullptr, nullptr, nullptr, nullptr, C2A, nullptr}; GEMM_PHASE(pg8::EM_QKV, BPTR(WS_HB), WPTR(WO_QKV), 3072, 1024, E); }
    SEAM(3);
    if (IN(4)) { attn_phase<0>(lds, G, bx, BPTR(WS_Q), nullptr, BPTR(WS_K), nullptr, BPTR(WS_V), BPTR(WS_Q), KARG(9)); convert_weights<1>(lane, gw, NGW); }
    SEAM(4);
    if (IN(5)) WO_PROJ(WS_Q, WO_AWO, 2);
    SEAM(5);
    if (IN(6)) FFN_IN(2, 1);
    SEAM(6);
    if (IN(7)) FFN_OUT(pg8::EM_RES, nullptr, 3, 1);
    SEAM(7);
    if (IN(8)) {
        { pg8::Epi<pg8::EM_KVDOWN> E{SSQ + 3 * M, i1024, BPTR(WS_CKV), BPTR(WS_KR), nullptr, nullptr, nullptr, SSQ + 4 * M, 1.f, ROPE}; GEMM_PHASE(pg8::EM_KVDOWN, BPTR(WS_HB), WPTR(WO_KVD), 512, 1024, E); }
        FFN_IN(3, 2);
    }
    SEAM(8);
    if (IN(9)) {
        { pg8::Epi<pg8::EM_KVUP> E{SSQ + 4 * M, 1.0f / 256.0f, BPTR(WS_KN), BPTR(WS_VB), nullptr, nullptr, nullptr, nullptr, 1.f, nullptr}; GEMM_PHASE(pg8::EM_KVUP, BPTR(WS_CKV), WPTR(WO_KVU), 2048, 256, E); }
        FFN_OUT(pg8::EM_RES, nullptr, 5, 2);
    }
    SEAM(9);
    if (IN(10)) { pg8::Epi<pg8::EM_DQ> E{SSQ + 5 * M, i1024, BPTR(WS_CQ), nullptr, nullptr, nullptr, nullptr, SSQ + 6 * M, 1.f, nullptr}; GEMM_PHASE(pg8::EM_DQ, BPTR(WS_HB), WPTR(WO_DQ), 768, 1024, E); }
    SEAM(10);
    if (IN(11)) { pg8::Epi<pg8::EM_UQ> E{SSQ + 6 * M, 1.0f / 768.0f, BPTR(WS_QN), BPTR(WS_QR), nullptr, nullptr, nullptr, nullptr, C2B, ROPE}; GEMM_PHASE(pg8::EM_UQ, BPTR(WS_CQ), WPTR(WO_UQ), 1536, 768, E); }
    SEAM(11);
    if (IN(12)) attn_phase<1>(lds, G, bx, BPTR(WS_QN), BPTR(WS_QR), BPTR(WS_KN), BPTR(WS_KR), BPTR(WS_VB), BPTR(WS_QN), nullptr);
    SEAM(12);
    if (IN(13)) WO_PROJ(WS_QN, WO_BWO, 7);
    SEAM(13);
    if (IN(14)) FFN_IN(7, 3);
    SEAM(14);
    if (IN(15)) FFN_OUT(pg8::EM_RES_F, nullptr, 8, 3);
    SEAM(15);
    if (IN(16)) {
        float* hres = HRES; const float* ssq = SSQ; const float* final_norm = KARG(19);
        for (int m = gw; m < M; m += NGW) {
            const float rs = __builtin_amdgcn_rsqf(ssq[8 * M + m] * i1024 + pg8::RMS_EPS);
            f32x4* xr = (f32x4*)(hres + (size_t)m * D) + lane; const f32x4* gr = (const f32x4*)final_norm + lane;
#pragma unroll
            for (int j = 0; j < 4; ++j) { const f32x4 v = xr[64 * j], g = gr[64 * j]; __builtin_nontemporal_store(v * rs * g, xr + 64 * j); }
        }
    }
#undef IN
#undef SEAM
}

#ifndef MK_MULTI
#define MK_MULTI 0
#endif
extern "C" void kernel_launch(void* const* d_in, const int* in_sizes, int n_in, void* d_out, int out_size, void* d_ws, size_t ws_size, hipStream_t stream) {
    static int grid = 0;
    if (grid == 0) {
        int dev = 0, cus = 0, per_cu = 0;
        hipGetDevice(&dev);
        hipDeviceGetAttribute(&cus, hipDeviceAttributeMultiprocessorCount, dev);
        hipFuncSetAttribute((const void*)yoco_fwd, hipFuncAttributeMaxDynamicSharedMemorySize, LDS_BYTES);
        hipOccupancyMaxActiveBlocksPerMultiprocessor(&per_cu, (const void*)yoco_fwd, NTHREADS, LDS_BYTES);
        if (per_cu < 1) per_cu = 1;
        grid = cus * 1;
        if (n_in != 20 || ws_size < WS_END) { fprintf(stderr, "kernel_launch: unexpected n_in %d / ws_size %zu (need %zu)\n", n_in, ws_size, (size_t)WS_END); }
        (void)hipGetLastError();
    }
    (void)hipMemsetAsync((char*)d_ws + WS_CTL, 0, CTL_BYTES, stream);
    Args a{};
    for (int i = 0; i < 20; ++i) a.in[i] = (const float*)d_in[i];
    a.out = (float*)d_out; a.ws = (unsigned char*)d_ws;
#if MK_MULTI
    for (int p = 0; p < 17; ++p) { a.ph_lo = p; a.ph_hi = p + 1; void* kargs[] = {&a};
        hipLaunchCooperativeKernel((const void*)yoco_fwd, dim3(grid), dim3(NTHREADS), kargs, LDS_BYTES, stream); }
#else
    a.ph_lo = 0; a.ph_hi = 17; void* kargs[] = {&a};
    hipError_t e = hipLaunchCooperativeKernel((const void*)yoco_fwd, dim3(grid), dim3(NTHREADS), kargs, LDS_BYTES, stream);
    if (e != hipSuccess) fprintf(stderr, "cooperative launch failed: %s (grid %d)\n", hipGetErrorString(e), grid);
#endif
}
```

```cpp
#include <hip/hip_runtime.h>
namespace pg8 {
#define PG8_LAS __attribute__((address_space(3)))
typedef unsigned short bf16_t;
typedef short bf16x8 __attribute__((ext_vector_type(8)));
typedef float f32x4 __attribute__((ext_vector_type(4)));
typedef unsigned u32x4 __attribute__((ext_vector_type(4)));
constexpr int BM = 256, BK = 64, HALF = 128, HTB = HALF * BK * 2  , STAGE_BYTES = 8 * HTB, NXCD = 8, WGM = 8;

__host__ __device__ __forceinline__ int lds_byte(int r, int c) { const int st = (r >> 4) * 2 + (c >> 5), rr = r & 15, cc = c & 31, ob = rr * 64 + cc * 2; return st * 1024 + (ob ^ (((ob >> 9) & 1) << 5)); }
__host__ __device__ __forceinline__ void stage_rc(int b, int& R, int& C) { const int st = b / 1024, sb = b % 1024, swz = sb ^ (((sb >> 9) & 1) << 5); R = (st >> 1) * 16 + swz / 64; C = (st & 1) * 32 + (swz % 64) / 2; }
__host__ __device__ __forceinline__ int perm32(int rho) { const int n = rho >> 4, i = rho & 15; return 8 * (i >> 2) + 4 * n + (i & 3); }

struct Unit { int pm, pn; };
struct Gemm { const bf16_t* A; const bf16_t* Bt; int M, N, K; };

struct StaticOrder {
    int nM, nN, nwg, G, c;
    __host__ __device__ void init(int M, int N, int G_, int c_) { nM = M / BM; nN = N / BM; nwg = nM * nN; G = G_; c = c_; }
    __host__ __device__ bool next(int i, Unit& u) const {
        const long L = (long)i * G + c; if (L >= nwg) return false;
        int wgid = (int)L; { const int q = nwg / NXCD, r = nwg % NXCD, xcd = wgid % NXCD, off = wgid / NXCD; wgid = (xcd < r ? xcd * (q + 1) : r * (q + 1) + (xcd - r) * q) + off; }
        const int nig = WGM * nN, gid = wgid / nig, fm = gid * WGM, gsz = (nM - fm) < WGM ? (nM - fm) : WGM;
        u.pm = fm + ((wgid % nig) % gsz); u.pn = (wgid % nig) / gsz; return true;
    }
    __device__ __forceinline__ void a_ready(const Unit&) const {}
    __device__ __forceinline__ void done(const Unit&) const {}
};


__device__ __forceinline__ unsigned cvt_pk_bf16(float lo, float hi) {
    typedef float f2_t __attribute__((ext_vector_type(2))); typedef __bf16 b2_t __attribute__((ext_vector_type(2)));
    f2_t v = {lo, hi}; b2_t b = __builtin_convertvector(v, b2_t); return __builtin_bit_cast(unsigned, b);
}
__device__ __forceinline__ u32x4 pack8(const f32x4 a, const f32x4 b) { u32x4 w; w.x = cvt_pk_bf16(a[0], a[1]); w.y = cvt_pk_bf16(a[2], a[3]); w.z = cvt_pk_bf16(b[0], b[1]); w.w = cvt_pk_bf16(b[2], b[3]); return w; }
__device__ __forceinline__ float sq4(const f32x4 a) { return (a[0] * a[0] + a[1] * a[1]) + (a[2] * a[2] + a[3] * a[3]); }
__device__ __forceinline__ float silu_mul(float g, float u) { return g * __builtin_amdgcn_rcpf(1.0f + __builtin_amdgcn_exp2f(-1.4426950408889634f * g)) * u; }

__device__ __forceinline__ f32x4 swiglu4(const f32x4 g, const f32x4 u, float rs) {
    const f32x4 t = g * (rs * -1.4426950408889634f); f32x4 e;
#pragma unroll
    for (int i = 0; i < 4; ++i) e[i] = __builtin_amdgcn_exp2f(t[i]);
    e = e + 1.0f; f32x4 r;
#pragma unroll
    for (int i = 0; i < 4; ++i) r[i] = __builtin_amdgcn_rcpf(e[i]);
    return (g * u) * (r * (rs * rs));
}
enum { EM_SWIGLU = 0, EM_RES = 1, EM_QKV = 2, EM_KVDOWN = 3, EM_KVUP = 4, EM_DQ = 5, EM_UQ = 6, EM_RES_X = 7, EM_RES_F = 8 };
constexpr float RMS_EPS = 1e-6f;
template <int MODE> struct Epi {
    static constexpr bool PERM = true, AFTER_DRAIN = false;
    const float* ssq_in; float inv_n;
    bf16_t* o0; bf16_t* o1; bf16_t* o2;
    const float* hold; float* hnew;
    float* ssq_out;
    float scale;
    const float* rope;
    __device__ __forceinline__ void operator()(const f32x4 (&acc)[2][2][4][2], const Unit& u, int wr, int wc, int fr, int fq) const {
        const int cb = wc * 32 + 8 * fq;
        if (MODE == EM_RES || MODE == EM_RES_X || MODE == EM_RES_F) {
            if (MODE == EM_RES_X) {
#pragma unroll
                for (int ai = 0; ai < 2; ++ai) {
                    f32x4 pre[4][2][2];
#pragma unroll
                    for (int m = 0; m < 4; ++m)
#pragma unroll
                        for (int bj = 0; bj < 2; ++bj) { const size_t off = (size_t)(u.pm * BM + ai * HALF + wr * 64 + m * 16 + fr) * 1024 + u.pn * BM + bj * HALF + cb;
                            pre[m][bj][0] = *(const f32x4*)(hold + off); pre[m][bj][1] = *(const f32x4*)(hold + off + 4); }
#pragma unroll
                    for (int m = 0; m < 4; ++m) { const int row = u.pm * BM + ai * HALF + wr * 64 + m * 16 + fr; float s = 0.f;
#pragma unroll
                        for (int bj = 0; bj < 2; ++bj) { const size_t off = (size_t)row * 1024 + u.pn * BM + bj * HALF + cb;
                            const f32x4 n0 = pre[m][bj][0] + acc[ai][bj][m][0] * scale, n1 = pre[m][bj][1] + acc[ai][bj][m][1] * scale;
                            *(u32x4*)(o0 + off) = pack8(n0, n1); s += sq4(n0) + sq4(n1); }
                        s += __shfl_xor(s, 16); s += __shfl_xor(s, 32);
                        if (fq == 0) unsafeAtomicAdd(ssq_out + row, s); }
                }
                return;
            }
            u32x4 prw[2][4][2];
#pragma unroll
            for (int ai = 0; ai < 2; ++ai)
#pragma unroll
                for (int m = 0; m < 4; ++m)
#pragma unroll
                    for (int bj = 0; bj < 2; ++bj) prw[ai][m][bj] = *(const u32x4*)(o0 + (size_t)(u.pm * BM + ai * HALF + wr * 64 + m * 16 + fr) * 1024 + u.pn * BM + bj * HALF + cb);
#pragma unroll
            for (int ai = 0; ai < 2; ++ai)
#pragma unroll
                for (int m = 0; m < 4; ++m) { const int row = u.pm * BM + ai * HALF + wr * 64 + m * 16 + fr; float s = 0.f;
#pragma unroll
                    for (int bj = 0; bj < 2; ++bj) { const size_t off = (size_t)row * 1024 + u.pn * BM + bj * HALF + cb; const u32x4 w = prw[ai][m][bj];
                        const f32x4 p0 = (f32x4){__builtin_bit_cast(float, w.x << 16), __builtin_bit_cast(float, w.x & 0xffff0000u), __builtin_bit_cast(float, w.y << 16), __builtin_bit_cast(float, w.y & 0xffff0000u)};
                        const f32x4 p1 = (f32x4){__builtin_bit_cast(float, w.z << 16), __builtin_bit_cast(float, w.z & 0xffff0000u), __builtin_bit_cast(float, w.w << 16), __builtin_bit_cast(float, w.w & 0xffff0000u)};
                        const f32x4 n0 = p0 + acc[ai][bj][m][0] * scale, n1 = p1 + acc[ai][bj][m][1] * scale;
                        if (MODE == EM_RES_F) { *(f32x4*)(hnew + off) = n0; *(f32x4*)(hnew + off + 4) = n1; }
                        else *(u32x4*)(o0 + off) = pack8(n0, n1);
                        s += sq4(n0) + sq4(n1); }
                    s += __shfl_xor(s, 16); s += __shfl_xor(s, 32);
                    if (fq == 0) unsafeAtomicAdd(ssq_out + row, s); }
            return;
        }
#pragma unroll
        for (int ai = 0; ai < 2; ++ai)
#pragma unroll
            for (int m = 0; m < 4; ++m) {
                const int row = u.pm * BM + ai * HALF + wr * 64 + m * 16 + fr;
                float rs = 1.f;
                rs = __builtin_amdgcn_rsqf(ssq_in[row] * inv_n + RMS_EPS);
                if (MODE == EM_SWIGLU) {
                    f32x4 a0, a1;
#pragma unroll
                    for (int e = 0; e < 1; ++e) { a0 = swiglu4(acc[ai][0][m][0], acc[ai][1][m][0], rs); a1 = swiglu4(acc[ai][0][m][1], acc[ai][1][m][1], rs); }
                    *(u32x4*)(o0 + (size_t)row * 2816 + u.pn * 128 + cb) = pack8(a0, a1);
                } else if (MODE == EM_QKV) {
                    const int t = u.pn >> 2; bf16_t* base = o0 + (size_t)t * ((size_t)32768 * 1024); const float sc = (t == 0) ? rs * scale : rs;
#pragma unroll
                    for (int bj = 0; bj < 2; ++bj)
                        *(u32x4*)(base + (size_t)row * 1024 + (u.pn & 3) * BM + bj * HALF + cb) = pack8(acc[ai][bj][m][0] * sc, acc[ai][bj][m][1] * sc);
                } else if (MODE == EM_KVDOWN) {
                    if (u.pn == 0) {
                        float s = 0.f;
#pragma unroll
                        for (int bj = 0; bj < 2; ++bj) { const f32x4 v0 = acc[ai][bj][m][0] * rs, v1 = acc[ai][bj][m][1] * rs; s += sq4(v0) + sq4(v1);
                            *(u32x4*)(o0 + (size_t)row * 256 + bj * HALF + cb) = pack8(v0, v1); }
                        s += __shfl_xor(s, 16); s += __shfl_xor(s, 32);
                        if (fq == 0) unsafeAtomicAdd(ssq_out + row, s);
                    } else if (wc == 0) {
                        const int pos = row & 2047; const float* rp = rope + ((size_t)pos * 32 + 8 * fq) * 2;
                        f32x4 y0a, y0b, y1a, y1b;
#pragma unroll
                        for (int e = 0; e < 4; ++e) {
                            { const float x1 = rs * acc[ai][0][m][0][e], x2 = rs * acc[ai][1][m][0][e], c = rp[2 * e], sn = rp[2 * e + 1]; y0a[e] = x1 * c - x2 * sn; y1a[e] = x2 * c + x1 * sn; }
                            { const float x1 = rs * acc[ai][0][m][1][e], x2 = rs * acc[ai][1][m][1][e], c = rp[8 + 2 * e], sn = rp[8 + 2 * e + 1]; y0b[e] = x1 * c - x2 * sn; y1b[e] = x2 * c + x1 * sn; }
                        }
                        *(u32x4*)(o1 + (size_t)row * 64 + 8 * fq) = pack8(y0a, y0b);
                        *(u32x4*)(o1 + (size_t)row * 64 + 32 + 8 * fq) = pack8(y1a, y1b);
                    }
                } else if (MODE == EM_KVUP) {
                    *(u32x4*)(o0 + (size_t)row * 1024 + u.pn * 128 + cb) = pack8(acc[ai][0][m][0] * rs, acc[ai][0][m][1] * rs);
                    *(u32x4*)(o1 + (size_t)row * 1024 + u.pn * 128 + cb) = pack8(acc[ai][1][m][0] * rs, acc[ai][1][m][1] * rs);
                } else if (MODE == EM_DQ) {
                    float s = 0.f;
#pragma unroll
                    for (int bj = 0; bj < 2; ++bj) { const f32x4 v0 = acc[ai][bj][m][0] * rs, v1 = acc[ai][bj][m][1] * rs; s += sq4(v0) + sq4(v1);
                        *(u32x4*)(o0 + (size_t)row * 768 + u.pn * BM + bj * HALF + cb) = pack8(v0, v1); }
                    s += __shfl_xor(s, 16); s += __shfl_xor(s, 32);
                    if (fq == 0) unsafeAtomicAdd(ssq_out + row, s);
                } else if (MODE == EM_UQ) {
                    const float sc = rs * scale;
                    if (u.pn < 4) {
#pragma unroll
                        for (int bj = 0; bj < 2; ++bj)
                            *(u32x4*)(o0 + (size_t)row * 1024 + u.pn * BM + bj * HALF + cb) = pack8(acc[ai][bj][m][0] * sc, acc[ai][bj][m][1] * sc);
                    } else {
                        const int head = (u.pn - 4) * 4 + wc; const int pos = row & 2047; const float* rp = rope + ((size_t)pos * 32 + 8 * fq) * 2;
                        f32x4 y0a, y0b, y1a, y1b;
#pragma unroll
                        for (int e = 0; e < 4; ++e) {
                            { const float x1 = sc * acc[ai][0][m][0][e], x2 = sc * acc[ai][1][m][0][e], c = rp[2 * e], sn = rp[2 * e + 1]; y0a[e] = x1 * c - x2 * sn; y1a[e] = x2 * c + x1 * sn; }
                            { const float x1 = sc * acc[ai][0][m][1][e], x2 = sc * acc[ai][1][m][1][e], c = rp[8 + 2 * e], sn = rp[8 + 2 * e + 1]; y0b[e] = x1 * c - x2 * sn; y1b[e] = x2 * c + x1 * sn; }
                        }
                        *(u32x4*)(o1 + (size_t)row * 512 + head * 64 + 8 * fq) = pack8(y0a, y0b);
                        *(u32x4*)(o1 + (size_t)row * 512 + head * 64 + 32 + 8 * fq) = pack8(y1a, y1b);
                    }
                }
            }
    }
};

template <class Epi, class Sched, bool ALIGN_EPI = false, bool SP2 = false>
__device__ __forceinline__ void gemm_phase(PG8_LAS unsigned char* lds, const Gemm g, const Sched& S, const Epi& E) {
    int tid_ = threadIdx.x; asm volatile("" : "+v"(tid_));
    const int tid = tid_, wid = __builtin_amdgcn_readfirstlane(tid >> 6), lane = tid & 63, wr = wid >> 2, wc = wid & 3, fr = lane & 15, fq = lane >> 4;
    const int K = g.K, nt = K / BK;
    unsigned voffA[2], voffB[2];
#pragma unroll
    for (int i = 0; i < 2; ++i) { int R, C; stage_rc(tid * 16 + i * 8192, R, C); const int Rb = Epi::PERM ? ((R & ~31) + perm32(R & 31)) : R;
        voffA[i] = (unsigned)(R * K + C) * 2u; voffB[i] = (unsigned)(Rb * K + C) * 2u; }
    const size_t kstep = (size_t)(BK * 2);
    const size_t hstep = (size_t)HALF * K * 2;
    const size_t tstep = 2 * hstep;
    const unsigned ldsw = (unsigned)wid * 1024u;
    const int aoff = lds_byte(wr * 64 + fr, fq * 8), boff = lds_byte(wc * 32 + fr, fq * 8);
#define PG8_SA(b, h) (((b) * 2 + (h)) * HTB)
#define PG8_SB(b, h) ((4 + (b) * 2 + (h)) * HTB)
#define PG8_STAGE(bufoff, gbase, voff) do { _Pragma("unroll") for (int _i = 0; _i < 2; ++_i) \
        __builtin_amdgcn_global_load_lds((const unsigned*)((const char*)(gbase) + (voff)[_i]), (PG8_LAS unsigned*)(lds + (bufoff) + ldsw + _i * 8192), 16, 0, 0); } while (0)
#define PG8_LDA(dst, b, h) do { _Pragma("unroll") for (int m = 0; m < 4; ++m) _Pragma("unroll") for (int k = 0; k < 2; ++k) dst[m][k] = *(const PG8_LAS bf16x8*)(lds + PG8_SA(b, h) + aoff + m * 2048 + k * 1024); } while (0)
#define PG8_LDB(dst, b, h) do { _Pragma("unroll") for (int n = 0; n < 2; ++n) _Pragma("unroll") for (int k = 0; k < 2; ++k) dst[n][k] = *(const PG8_LAS bf16x8*)(lds + PG8_SB(b, h) + boff + n * 2048 + k * 1024); } while (0)
#define PG8_MMA(ai, bj, At, Bt) do { __builtin_amdgcn_s_setprio(1); _Pragma("unroll") for (int m = 0; m < 4; ++m) _Pragma("unroll") for (int n = 0; n < 2; ++n) _Pragma("unroll") for (int k = 0; k < 2; ++k) \
        acc[ai][bj][m][n] = __builtin_amdgcn_mfma_f32_16x16x32_bf16(Bt[n][k], At[m][k], acc[ai][bj][m][n], 0, 0, 0); __builtin_amdgcn_s_setprio(0); } while (0)
#define PG8_WAIT_V(n) asm volatile("s_waitcnt vmcnt(" #n ")" ::: "memory")
#define PG8_WAIT_L(n) asm volatile("s_waitcnt lgkmcnt(" #n ")" ::: "memory")
#define PG8_BAR __builtin_amdgcn_s_barrier()
#define PG8_SCHED __builtin_amdgcn_sched_barrier(0)
    Unit cur, nxt; int ui = 0;
    if (!S.next(0, cur)) return;
    f32x4 acc[2][2][4][2];
#pragma unroll
    for (int a = 0; a < 2; ++a)
#pragma unroll
        for (int b = 0; b < 2; ++b)
#pragma unroll
            for (int m = 0; m < 4; ++m)
#pragma unroll
                for (int n = 0; n < 2; ++n) acc[a][b][m][n] = (f32x4){0.f, 0.f, 0.f, 0.f};
    bf16x8 At[4][2], B0[2][2], B1[2][2];
    const char* cA = (const char*)g.A + (size_t)cur.pm * tstep; const char* cB = (const char*)g.Bt + (size_t)cur.pn * tstep;
    S.a_ready(cur);
    if constexpr (SP2) {
        PG8_STAGE(PG8_SB(0, 0), cB, voffB); PG8_STAGE(PG8_SB(0, 1), cB + hstep, voffB); PG8_STAGE(PG8_SA(0, 0), cA, voffA); PG8_STAGE(PG8_SA(0, 1), cA + hstep, voffA);
        if (wr == 1) PG8_BAR;
        PG8_WAIT_V(2); PG8_BAR;
        PG8_STAGE(PG8_SB(1, 0), cB + kstep, voffB); PG8_STAGE(PG8_SA(1, 0), cA + kstep, voffA); PG8_STAGE(PG8_SB(1, 1), cB + hstep + kstep, voffB);
        PG8_WAIT_V(6); PG8_BAR;
    } else {
        PG8_STAGE(PG8_SB(0, 0), cB, voffB); PG8_STAGE(PG8_SA(0, 0), cA, voffA); PG8_STAGE(PG8_SB(0, 1), cB + hstep, voffB); PG8_STAGE(PG8_SA(0, 1), cA + hstep, voffA);
        if (wr == 1) PG8_BAR;
        PG8_WAIT_V(4); PG8_BAR;
        PG8_STAGE(PG8_SB(1, 0), cB + kstep, voffB); PG8_STAGE(PG8_SA(1, 0), cA + kstep, voffA); PG8_STAGE(PG8_SB(1, 1), cB + hstep + kstep, voffB);
        PG8_WAIT_V(6); PG8_BAR;
    }
    for (;;) {
        const bool has_next = S.next(ui + 1, nxt);
        const char* nA = has_next ? (const char*)g.A + (size_t)nxt.pm * tstep : cA; const char* nB = has_next ? (const char*)g.Bt + (size_t)nxt.pn * tstep : cB;
        for (int t = 0; t < nt; t += 2) {
            const bool last = (t == nt - 2);
            const char* a1 = cA + (size_t)(t + 1) * kstep;
            const char* a2 = last ? nA : cA + (size_t)(t + 2) * kstep; const char* b2 = last ? nB : cB + (size_t)(t + 2) * kstep;
            const char* a3 = a2 + kstep; const char* b3 = b2 + kstep;
            if (last && has_next) S.a_ready(nxt);
            if constexpr (SP2) {
            PG8_LDB(B0, 0, 0); PG8_LDB(B1, 0, 1); PG8_SCHED; PG8_LDA(At, 0, 0); PG8_STAGE(PG8_SA(1, 1), a1 + hstep, voffA);
            PG8_WAIT_V(8); PG8_WAIT_L(0); PG8_BAR; PG8_MMA(0, 0, At, B0); PG8_MMA(0, 1, At, B1); PG8_BAR; PG8_SCHED;
            PG8_LDA(At, 0, 1); PG8_STAGE(PG8_SB(0, 0), b2, voffB); PG8_STAGE(PG8_SB(0, 1), b2 + hstep, voffB); PG8_STAGE(PG8_SA(0, 0), a2, voffA);
            PG8_WAIT_V(8); PG8_WAIT_L(0); PG8_BAR; PG8_MMA(1, 0, At, B0); PG8_MMA(1, 1, At, B1); PG8_BAR; PG8_SCHED;
            PG8_LDB(B0, 1, 0); PG8_LDB(B1, 1, 1); PG8_SCHED; PG8_LDA(At, 1, 0); PG8_STAGE(PG8_SA(0, 1), a2 + hstep, voffA);
            PG8_WAIT_V(8); PG8_WAIT_L(0); PG8_BAR; PG8_MMA(0, 0, At, B0); PG8_MMA(0, 1, At, B1); PG8_BAR; PG8_SCHED;
            PG8_LDA(At, 1, 1); PG8_STAGE(PG8_SB(1, 0), b3, voffB); PG8_STAGE(PG8_SB(1, 1), b3 + hstep, voffB); PG8_STAGE(PG8_SA(1, 0), a3, voffA);
            PG8_WAIT_V(8); PG8_WAIT_L(0); PG8_BAR; PG8_MMA(1, 0, At, B0); PG8_MMA(1, 1, At, B1); PG8_BAR; PG8_SCHED;
            } else {
            PG8_LDB(B0, 0, 0); PG8_SCHED; PG8_LDA(At, 0, 0); PG8_STAGE(PG8_SA(1, 1), a1 + hstep, voffA);
            PG8_WAIT_L(8); PG8_BAR; PG8_WAIT_L(0); PG8_MMA(0, 0, At, B0); PG8_BAR; PG8_SCHED;
            PG8_LDB(B1, 0, 1); PG8_STAGE(PG8_SB(0, 0), b2, voffB);
            PG8_BAR; PG8_WAIT_L(0); PG8_MMA(0, 1, At, B1); PG8_BAR;
            PG8_LDA(At, 0, 1); PG8_STAGE(PG8_SA(0, 0), a2, voffA);
            PG8_BAR; PG8_WAIT_L(0); PG8_MMA(1, 0, At, B0); PG8_BAR; PG8_SCHED;
            PG8_STAGE(PG8_SB(0, 1), b2 + hstep, voffB);
            PG8_WAIT_V(6); PG8_BAR; PG8_MMA(1, 1, At, B1); PG8_BAR;
            PG8_LDB(B0, 1, 0); PG8_SCHED; PG8_LDA(At, 1, 0); PG8_STAGE(PG8_SA(0, 1), a2 + hstep, voffA);
            PG8_WAIT_L(8); PG8_BAR; PG8_WAIT_L(0); PG8_MMA(0, 0, At, B0); PG8_BAR; PG8_SCHED;
            PG8_LDB(B1, 1, 1); PG8_STAGE(PG8_SB(1, 0), b3, voffB);
            PG8_BAR; PG8_WAIT_L(0); PG8_MMA(0, 1, At, B1); PG8_BAR;
            PG8_LDA(At, 1, 1); PG8_STAGE(PG8_SA(1, 0), a3, voffA);
            PG8_BAR; PG8_WAIT_L(0); PG8_MMA(1, 0, At, B0); PG8_BAR; PG8_SCHED;
            PG8_STAGE(PG8_SB(1, 1), b3 + hstep, voffB);
            PG8_WAIT_V(6); PG8_BAR; PG8_MMA(1, 1, At, B1); PG8_BAR;
            }
        }
        if constexpr (ALIGN_EPI) { if (wr == 0) PG8_BAR; }
        if constexpr (!Epi::AFTER_DRAIN) { E(acc, cur, wr, wc, fr, fq); S.done(cur); }
        if (!has_next) break;
#pragma unroll
        for (int a = 0; a < 2; ++a)
#pragma unroll
            for (int b = 0; b < 2; ++b)
#pragma unroll
                for (int m = 0; m < 4; ++m)
#pragma unroll
                    for (int n = 0; n < 2; ++n) acc[a][b][m][n] = (f32x4){0.f, 0.f, 0.f, 0.f};
        cur = nxt; cA = nA; cB = nB; ++ui;
        if constexpr (ALIGN_EPI) { if (wr == 1) PG8_BAR; }
    }
    PG8_WAIT_V(0);
    if constexpr (!ALIGN_EPI) { if (wr == 0) PG8_BAR; }
    PG8_BAR;
    if constexpr (Epi::AFTER_DRAIN) { E.fused(acc, cur, wr, wc, fr, fq, lds, wid, lane); S.done(cur); }
#undef PG8_SA
#undef PG8_SB
#undef PG8_STAGE
#undef PG8_LDA
#undef PG8_LDB
#undef PG8_MMA
#undef PG8_WAIT_V
#undef PG8_WAIT_L
#undef PG8_BAR
#undef PG8_SCHED
}
}

#include <hip/hip_cooperative_groups.h>
#include <cstdio>
#include <cstdint>
namespace cg = cooperative_groups;
#define LAS __attribute__((address_space(3)))
typedef unsigned short bf16;
typedef float f32x4 __attribute__((ext_vector_type(4)));
typedef float f32x16 __attribute__((ext_vector_type(16)));
typedef short bf16x8 __attribute__((ext_vector_type(8)));
typedef unsigned u32x4 __attribute__((ext_vector_type(4)));
typedef unsigned u32x2 __attribute__((ext_vector_type(2)));
typedef short s16x4 __attribute__((ext_vector_type(4)));

constexpr int NWAVES = 8, NTHREADS = 512;
constexpr int BATCH = 16, SEQ = 2048, D = 1024, M = BATCH * SEQ, FF = 2816;
constexpr int LDS_BYTES = 131072 + 256, MISC_OFF = 131072;
constexpr size_t MiB = 1u << 20;
constexpr size_t WS_SSQ = 0;
constexpr size_t WS_ROPE = 2 * MiB;
constexpr size_t WS_CTL = 3 * MiB, CTL_BYTES = 16384;
constexpr size_t WS_W = 4 * MiB;
constexpr size_t W_FFIN = (size_t)5632 * 1024 * 2, W_FFOUT = (size_t)1024 * 2816 * 2;
constexpr size_t WO_FFIN0 = 0, WO_FFOUT0 = WO_FFIN0 + 4 * W_FFIN;
constexpr size_t WO_QKV = WO_FFOUT0 + 4 * W_FFOUT, WO_AWO = WO_QKV + (size_t)3072 * 1024 * 2, WO_KVD = WO_AWO + (size_t)1024 * 1024 * 2;
constexpr size_t WO_KVU = WO_KVD + (size_t)512 * 1024 * 2, WO_DQ = WO_KVU + (size_t)2048 * 256 * 2, WO_UQ = WO_DQ + (size_t)768 * 1024 * 2;
constexpr size_t WO_BWO = WO_UQ + (size_t)1536 * 768 * 2, WO_END = WO_BWO + (size_t)1024 * 1024 * 2;
static_assert(WO_END <= 96 * MiB, "weights fit");
constexpr size_t WS_HB = 100 * MiB;
constexpr size_t WS_BIG = 164 * MiB;
constexpr size_t WS_ACT = WS_BIG, WS_Q = WS_BIG, WS_K = WS_BIG + 64 * MiB, WS_V = WS_BIG + 128 * MiB;
constexpr size_t WS_QN = WS_BIG, WS_QR = WS_BIG + 64 * MiB, WS_CQ = WS_BIG + 96 * MiB;
constexpr size_t WS_KN = 356 * MiB, WS_VB = WS_KN + 64 * MiB, WS_CKV = WS_VB + 64 * MiB, WS_KR = WS_CKV + 16 * MiB, WS_END = WS_KR + 4 * MiB;
static_assert(WS_END <= 512 * MiB, "ws map");

__device__ __forceinline__ unsigned f2bf(float f) { unsigned u = __builtin_bit_cast(unsigned, f); return (u + 0x7fffu + ((u >> 16) & 1u)) >> 16; }
__device__ __forceinline__ unsigned pk2(float lo, float hi) { return f2bf(lo) | (f2bf(hi) << 16); }
__device__ __forceinline__ float wave_sum(float v) {
#pragma unroll
    for (int o = 1; o < 64; o <<= 1) v += __shfl_xor(v, o);
    return v;
}

enum { MAP_ID = 0, MAP_SWIGLU = 1, MAP_KVDOWN = 2, MAP_UQ = 3 };
template <int MAP> __device__ __forceinline__ int map_col(int np) {
    if (MAP == MAP_ID) return np;
    if (MAP == MAP_SWIGLU) { const int t = np >> 8, rem = np & 255, half = rem >> 7, c = rem & 127; return half * 2816 + 128 * t + c; }
    if (MAP == MAP_KVDOWN) { if (np < 256) return np; const int rem = np - 256, half = rem >> 7, c = rem & 127; return c < 32 ? 256 + 32 * half + c : -1; }
    if (np < 1024) { const int t = np >> 8, bj = (np >> 7) & 1, c = np & 127; return (2 * t + bj) * 192 + c; }
    { const int rem = np - 1024, t = rem >> 8, half = (rem >> 7) & 1, c = rem & 127, head = t * 4 + (c >> 5); return head * 192 + 128 + 32 * half + (c & 31); }
}
template <int MAP> __device__ __forceinline__ void conv_item(const float* W, int K, int Nsrc, int NP, bf16* WT, const float* gain, int item, int lane) {
    const int nblk = NP / 128, kb0 = item / nblk, nb = item % nblk, k0 = 64 * kb0, n0 = 128 * nb;
    const int nq = lane & 31, kh = lane >> 5;
    const int s32 = map_col<MAP>(n0 + ((4 * nq) & ~31));
    const int src = s32 + ((4 * nq) & 31);
    bf16* dst = WT + (size_t)(n0 + 4 * nq) * K + k0 + 8 * kh;
    if (s32 < 0) {
#pragma unroll
        for (int kk = 0; kk < 4; ++kk)
#pragma unroll
            for (int c = 0; c < 4; ++c) *(u32x4*)(dst + (size_t)c * K + 16 * kk) = (u32x4){0u, 0u, 0u, 0u};
        return;
    }
#pragma unroll
    for (int kp = 0; kp < 2; ++kp) {
        f32x4 v[2][8]; f32x4 g0[2], g1[2];
#pragma unroll
        for (int k2 = 0; k2 < 2; ++k2) { const int kb = k0 + 16 * (2 * kp + k2) + 8 * kh;
#pragma unroll
            for (int j = 0; j < 8; ++j) v[k2][j] = __builtin_nontemporal_load((const f32x4*)(W + (size_t)(kb + j) * Nsrc + src));
            if (gain) { g0[k2] = *(const f32x4*)(gain + kb); g1[k2] = *(const f32x4*)(gain + kb + 4); } else { g0[k2] = (f32x4){1.f, 1.f, 1.f, 1.f}; g1[k2] = g0[k2]; } }
#pragma unroll
        for (int k2 = 0; k2 < 2; ++k2)
#pragma unroll
            for (int c = 0; c < 4; ++c) { u32x4 o;
                o.x = pk2(v[k2][0][c] * g0[k2][0], v[k2][1][c] * g0[k2][1]); o.y = pk2(v[k2][2][c] * g0[k2][2], v[k2][3][c] * g0[k2][3]);
                o.z = pk2(v[k2][4][c] * g1[k2][0], v[k2][5][c] * g1[k2][1]); o.w = pk2(v[k2][6][c] * g1[k2][2], v[k2][7][c] * g1[k2][3]);
                *(u32x4*)(dst + (size_t)c * K + 16 * (2 * kp + k2)) = o; }
    }
}

struct Args {
    const float* in[20]; float* out; unsigned char* ws; int ph_lo, ph_hi, use_cg, pad;
};

template <int PASS> __device__ __forceinline__ void convert_weights(int lane, int gw, int NGW, int j0 = 0, int j1 = 1 << 20);
template <int MLA, int CONV = 0> __device__ __forceinline__ void attn_phase(LAS unsigned char* lds, int G, int cwg,
        const bf16* Q0, const bf16* Q1, const bf16* K0, const bf16* K1, const bf16* V, bf16* O, const float* rel_table) {
    constexpr int DQK = MLA ? 192 : 64, DV = MLA ? 128 : 64, NH = MLA ? 8 : 16, NKS = DQK / 16, NDB = DV / 32;
    constexpr int KROW = DQK + 8, VROW = DV + 32;
    constexpr int KCH = DQK / 8, NKC = 64 * KCH / NTHREADS;
    constexpr int NVC = 64 * (DV / 8) / NTHREADS;
    LAS bf16* Ks = (LAS bf16*)lds;
    LAS bf16* Vt = (LAS bf16*)(lds + 64 * KROW * 2);
    LAS float* Bt = (LAS float*)(lds + 64 * KROW * 2 + 64 * VROW * 2);
    int tid_ = threadIdx.x; asm volatile("" : "+v"(tid_));
    const int tid = tid_, lane = tid & 63, wid = __builtin_amdgcn_readfirstlane(tid >> 6), r32 = lane & 31, hi = lane >> 5;
    const int nunits = BATCH * NH * 8;
    const int pi = 16 * (r32 >> 4) + 8 * ((r32 >> 2) & 1) + 4 * ((r32 >> 3) & 1) + (r32 & 3);
    for (int L = cwg; L < nunits; L += G) {
        int b, h, grp;
        if (MLA) { const int pair = L / (BATCH * NH), bh = L % (BATCH * NH); b = bh / NH; h = bh % NH; grp = (0x10235467 >> (4 * pair)) & 7; }
        else { grp = L / (BATCH * NH); const int bh = L % (BATCH * NH); b = bh / NH; h = bh % NH; }
        const int tok0 = b * SEQ;
        const int cq = 4 * grp + (wid >> 1);
        const int qrow = tok0 + 256 * grp + 32 * wid + r32;
        const int kc_lo = MLA ? 0 : ((4 * grp - 8) > 0 ? (4 * grp - 8) : 0), kc_hi = 4 * grp + 3;
        bf16x8 qf[NKS];
#pragma unroll
        for (int ks = 0; ks < NKS; ++ks) {
            const bf16* src;
            if (!MLA) src = Q0 + (size_t)qrow * 1024 + h * 64 + 16 * ks + 8 * hi;
            else src = (ks < 8) ? Q0 + (size_t)qrow * 1024 + h * 128 + 16 * ks + 8 * hi : Q1 + (size_t)qrow * 512 + h * 64 + 16 * (ks - 8) + 8 * hi;
            qf[ks] = *(const bf16x8*)src;
        }
        if (!MLA) { __syncthreads(); for (int i = tid; i < 257; i += NTHREADS) Bt[i] = rel_table[h * 257 + i] * 1.4426950408889634f; }
        f32x16 o[NDB];
#pragma unroll
        for (int db = 0; db < NDB; ++db)
#pragma unroll
            for (int r = 0; r < 16; ++r) o[db][r] = 0.f;
        float mrun = -1e30f, lrun = 0.f;
        u32x4 kreg[NKC], vreg[NVC];
        auto prefetch = [&](int kc) {
            const int t0 = tok0 + 64 * kc;
#pragma unroll
            for (int j = 0; j < NKC; ++j) { const int c = tid + NTHREADS * j, row = c / KCH, ch = c % KCH; const bf16* src;
                if (!MLA) src = K0 + (size_t)(t0 + row) * 1024 + h * 64 + ch * 8;
                else src = (ch < 16) ? K0 + (size_t)(t0 + row) * 1024 + h * 128 + ch * 8 : K1 + (size_t)(t0 + row) * 64 + (ch - 16) * 8;
                kreg[j] = *(const u32x4*)src; }
#pragma unroll
            for (int j = 0; j < NVC; ++j) { const int c = tid + NTHREADS * j, kv = c / (DV / 8), dch = c % (DV / 8);
                vreg[j] = *(const u32x4*)(V + (size_t)(t0 + kv) * 1024 + h * DV + dch * 8); }
        };
        prefetch(kc_lo);
        for (int kc = kc_lo; kc <= kc_hi; ++kc) {
            __syncthreads();
#pragma unroll
            for (int j = 0; j < NKC; ++j) { const int c = tid + NTHREADS * j, row = c / KCH, ch = c % KCH; *(LAS u32x4*)(Ks + row * KROW + ch * 8) = kreg[j]; }
#pragma unroll
            for (int j = 0; j < NVC; ++j) { const int c = tid + NTHREADS * j, kv = c / (DV / 8), dch = c % (DV / 8); *(LAS u32x4*)(Vt + kv * VROW + dch * 8) = vreg[j]; }
            __syncthreads();
            if (kc < kc_hi) prefetch(kc + 1);
            const bool active = MLA ? (kc <= cq) : (kc <= cq && kc >= cq - 8);
            if (active) {
                f32x16 st[2];
#pragma unroll
                for (int p = 0; p < 2; ++p)
#pragma unroll
                    for (int r = 0; r < 16; ++r) st[p][r] = 0.f;
                {
                    constexpr int NF = 2 * NKS, KLA = MLA ? 4 : 6;
                    bf16x8 kf[NF];
#define KREAD(f) kf[f] = *(const LAS bf16x8*)(Ks + (32 * ((f) & 1) + pi) * KROW + 16 * ((f) >> 1) + 8 * hi)
#pragma unroll
                    for (int f = 0; f < KLA; ++f) KREAD(f);
                    __builtin_amdgcn_sched_barrier(0);
#pragma unroll
                    for (int g = 0; g < NKS; ++g) {
                        st[0] = __builtin_amdgcn_mfma_f32_32x32x16_bf16(kf[2 * g], qf[g], st[0], 0, 0, 0);
                        st[1] = __builtin_amdgcn_mfma_f32_32x32x16_bf16(kf[2 * g + 1], qf[g], st[1], 0, 0, 0);
                        if (2 * g + KLA < NF) KREAD(2 * g + KLA);
                        if (2 * g + KLA + 1 < NF) KREAD(2 * g + KLA + 1);
                        __builtin_amdgcn_sched_barrier(0);
                    }
#undef KREAD
                }
                if (!MLA) {
                    if (cq - kc >= 3) {
                        const float cbias = Bt[256];
#pragma unroll
                        for (int p = 0; p < 2; ++p)
#pragma unroll
                            for (int r = 0; r < 16; ++r) st[p][r] += cbias;
                    } else {
                        const int base = 64 * (cq - kc) + 32 * (wid & 1) + r32 - 8 * hi + 128;
#pragma unroll
                        for (int p = 0; p < 2; ++p)
#pragma unroll
                            for (int r = 0; r < 16; ++r) { int idx = base - (32 * p + 16 * (r >> 3) + (r & 7)); idx = idx > 256 ? 256 : idx; st[p][r] += Bt[idx]; }
                    }
                }
                float mx = st[0][0];
#pragma unroll
                for (int p = 0; p < 2; ++p)
#pragma unroll
                    for (int r = 0; r < 16; ++r) mx = fmaxf(mx, st[p][r]);
                mx = fmaxf(mx, __shfl_xor(mx, 32));
                const float mnew = fmaxf(mrun, mx), alpha = __builtin_amdgcn_exp2f(mrun - mnew);
                mrun = mnew;
                float rsum = 0.f;
#pragma unroll
                for (int p = 0; p < 2; ++p)
#pragma unroll
                    for (int r = 0; r < 16; ++r) { st[p][r] = __builtin_amdgcn_exp2f(st[p][r] - mnew); rsum += st[p][r]; }
                lrun = lrun * alpha + rsum;
                if (__any(alpha != 1.0f)) {
#pragma unroll
                for (int db = 0; db < NDB; ++db)
#pragma unroll
                    for (int r = 0; r < 16; ++r) o[db][r] *= alpha;
                }
                bf16x8 pf[2][2];
#pragma unroll
                for (int p = 0; p < 2; ++p)
#pragma unroll
                    for (int s = 0; s < 2; ++s) { u32x4 w; w.x = pg8::cvt_pk_bf16(st[p][8 * s + 0], st[p][8 * s + 1]); w.y = pg8::cvt_pk_bf16(st[p][8 * s + 2], st[p][8 * s + 3]);
                        w.z = pg8::cvt_pk_bf16(st[p][8 * s + 4], st[p][8 * s + 5]); w.w = pg8::cvt_pk_bf16(st[p][8 * s + 6], st[p][8 * s + 7]); pf[p][s] = __builtin_bit_cast(bf16x8, w); }
                {
                    constexpr int NFV = 4 * NDB, VLA = MLA ? 2 : 4;
                    bf16x8 vf[NFV];
                    const LAS bf16* vbase = Vt + (8 * hi + ((lane & 15) >> 2)) * VROW + 16 * ((lane >> 4) & 1) + 4 * (lane & 3);
#define VREAD(f) do { const LAS bf16* vp_ = vbase + (32 * (((f) / NDB) >> 1) + 16 * (((f) / NDB) & 1)) * VROW + 32 * ((f) % NDB); \
                        const s16x4 vlo_ = __builtin_bit_cast(s16x4, __builtin_amdgcn_ds_read_tr16_b64_v4i16((LAS s16x4*)vp_)); \
                        const s16x4 vhi_ = __builtin_bit_cast(s16x4, __builtin_amdgcn_ds_read_tr16_b64_v4i16((LAS s16x4*)(vp_ + 4 * VROW))); \
                        vf[f] = __builtin_shufflevector(vlo_, vhi_, 0, 1, 2, 3, 4, 5, 6, 7); } while (0)
#pragma unroll
                    for (int f = 0; f < VLA; ++f) VREAD(f);
                    __builtin_amdgcn_sched_barrier(0);
#pragma unroll
                    for (int f = 0; f < NFV; ++f) {
                        o[f % NDB] = __builtin_amdgcn_mfma_f32_32x32x16_bf16(vf[f], pf[(f / NDB) >> 1][(f / NDB) & 1], o[f % NDB], 0, 0, 0);
                        if (f + VLA < NFV) VREAD(f + VLA);
                        __builtin_amdgcn_sched_barrier(0);
                    }
#undef VREAD
                }
            }
        }
        const float ltot = lrun + __shfl_xor(lrun, 32), rl = 1.0f / ltot;
        bf16* orow = O + (size_t)qrow * 1024 + h * DV;
#pragma unroll
        for (int db = 0; db < NDB; ++db)
#pragma unroll
            for (int j = 0; j < 2; ++j) {
                const unsigned ax = pg8::cvt_pk_bf16(o[db][8 * j] * rl, o[db][8 * j + 1] * rl), ay = pg8::cvt_pk_bf16(o[db][8 * j + 2] * rl, o[db][8 * j + 3] * rl);
                const unsigned bx = pg8::cvt_pk_bf16(o[db][8 * j + 4] * rl, o[db][8 * j + 5] * rl), by = pg8::cvt_pk_bf16(o[db][8 * j + 6] * rl, o[db][8 * j + 7] * rl);
                const auto sx = __builtin_amdgcn_permlane32_swap(ax, bx, false, false); const auto sy = __builtin_amdgcn_permlane32_swap(ay, by, false, false);
                u32x4 w; w.x = sx[0]; w.y = sy[0]; w.z = sx[1]; w.w = sy[1];
                *(u32x4*)(orow + 32 * db + 16 * j + 8 * hi) = w; }
        __syncthreads();
        if (CONV) { const int ucnt = (L - cwg) / G; convert_weights<1>(lane, (int)blockIdx.x * NWAVES + wid, G * NWAVES, ucnt, ucnt + 1); }
    }
    if (CONV) { const int udone = (nunits - cwg + G - 1) / G; convert_weights<1>(lane, (int)blockIdx.x * NWAVES + wid, G * NWAVES, udone > 0 ? udone : 0); }
}

#define RLX_AGENT __ATOMIC_RELAXED, __HIP_MEMORY_SCOPE_AGENT
#define XB_TMO      128
#define XB_XCNT(j)  (256  + 64 * (j))
#define XB_XSUB(j)  (1280 + 64 * (j))
#define XB_XGEN(j)  (2304 + 64 * (j))
#define XB_TOP      3328
#define XB_TOPGEN   3392
#define XCD_BAR_WORDS 3456
#define XB_SPIN_CAP (1u << 18)

__device__ __forceinline__ unsigned xb_ld(unsigned* p)              { return __hip_atomic_load(p, __ATOMIC_RELAXED, __HIP_MEMORY_SCOPE_AGENT); }
__device__ __forceinline__ unsigned xb_add(unsigned* p, unsigned v) { return __hip_atomic_fetch_add(p, v, __ATOMIC_RELAXED, __HIP_MEMORY_SCOPE_AGENT); }
__device__ __forceinline__ unsigned xb_xcc_id() { return (unsigned)__builtin_amdgcn_s_getreg((3 << 11) | 20) & 0xFu; }
#define XB_SPIN(cond, bar) do { unsigned _sp = 0; while (cond) { __builtin_amdgcn_s_sleep(1); \
    if ((++_sp & 255u) == 0u) { if (xb_ld(&(bar)[XB_TMO])) break; if (_sp > XB_SPIN_CAP) { atomicAdd(&(bar)[XB_TMO], 1u); break; } } } } while (0)

struct XcdBarrier {
    unsigned* bar; unsigned x;
    volatile LAS unsigned* st;
};

__device__ __forceinline__ XcdBarrier xcd_barrier_post(unsigned* bar, volatile LAS unsigned* st) {
    XcdBarrier b; b.bar = bar; b.x = xb_xcc_id(); b.st = st;
    if (threadIdx.x == 0) (void)xb_add(&bar[XB_XCNT(b.x)], 1u);
    return b;
}
__device__ __forceinline__ void xcd_barrier_complete(unsigned* bar, unsigned x, unsigned& nloc, unsigned& nx) {
    const unsigned G = gridDim.x * gridDim.y * gridDim.z;
    unsigned sum, cnt, mine, sp = 0u;
    for (;;) {
        sum = 0u; cnt = 0u; mine = 0u;
#pragma unroll
        for (unsigned j = 0; j < 16; ++j) { const unsigned c = xb_ld(&bar[XB_XCNT(j)]); sum += c; cnt += (c > 0u) ? 1u : 0u; mine = (j == x) ? c : mine; }
        if (sum == G) break;
        __builtin_amdgcn_s_sleep(1);
        if ((++sp & 255u) == 0u) { if (xb_ld(&bar[XB_TMO])) break; if (sp > XB_SPIN_CAP) { atomicAdd(&bar[XB_TMO], 1u); break; } }
    }
    nloc = mine > 0u ? mine : 1u; nx = cnt > 0u ? cnt : 1u;
}

__device__ __forceinline__ void xcd_barrier(const XcdBarrier& b) {
    asm volatile("s_waitcnt vmcnt(0)" ::: "memory");
    __syncthreads();
    if (threadIdx.x == 0) {
        unsigned* bar = b.bar;
        __builtin_amdgcn_s_waitcnt(0);
        unsigned nloc = b.st[0], nx = b.st[1];
        if (nloc == 0u) { xcd_barrier_complete(bar, b.x, nloc, nx); b.st[0] = nloc; b.st[1] = nx; }
        const unsigned old = xb_add(&bar[XB_XSUB(b.x)], 1u);
        const unsigned gen = old / nloc;
        if (old + 1u == (gen + 1u) * nloc) {
            __builtin_amdgcn_fence(__ATOMIC_RELEASE, "agent");
            asm volatile("s_waitcnt vmcnt(0)" ::: "memory");
            const unsigned og = xb_add(&bar[XB_TOP], 1u);
            const unsigned tg = og / nx;
            if (og + 1u == (tg + 1u) * nx) xb_add(&bar[XB_TOPGEN], 1u);
            else XB_SPIN(xb_ld(&bar[XB_TOPGEN]) == tg, bar);
            __builtin_amdgcn_fence(__ATOMIC_ACQUIRE, "agent");
            xb_add(&bar[XB_XGEN(b.x)], 1u);
            asm volatile("s_waitcnt vmcnt(0)" ::: "memory");
        } else {
            XB_SPIN(xb_ld(&bar[XB_XGEN(b.x)]) == gen, bar);
            __builtin_amdgcn_fence(__ATOMIC_ACQUIRE, "agent");
            asm volatile("s_waitcnt vmcnt(0)" ::: "memory");
        }
    }
    __syncthreads();
}

__device__ __forceinline__ const void* karg_ptr(int i) {
    const __attribute__((address_space(4))) char* kp = (const __attribute__((address_space(4))) char*)__builtin_amdgcn_kernarg_segment_ptr();
    asm volatile("" : "+s"(kp));
    return *(const void* const __attribute__((address_space(4)))*)(kp + 8 * i);
}
#define KARG(i) ((const float*)karg_ptr(i))
#define WSP ((unsigned char*)karg_ptr(21))
#define HRES ((float*)karg_ptr(20))
#define SSQ ((float*)(WSP + WS_SSQ))
#define ROPE ((float*)(WSP + WS_ROPE))
#define WPTR(off) ((bf16*)(WSP + WS_W + (off)))
#define BPTR(off) ((bf16*)(WSP + (off)))
template <int PASS> __device__ __forceinline__ void convert_weights(int lane, int gw, int NGW, int j0, int j1) {
        constexpr int I_FFIN = 16 * 44, I_FFOUT = 44 * 8, I_QKV = 16 * 24, I_WO = 16 * 8, I_KVD = 16 * 4, I_KVU = 4 * 16, I_DQ = 16 * 6, I_UQ = 12 * 12;
        constexpr int NFM = PASS == 0 ? 1 : 3, W0 = PASS == 0 ? 0 : 1;
        constexpr int NITEMS = PASS == 0 ? (I_FFIN + I_FFOUT + I_QKV) : (3 * I_FFIN + 3 * I_FFOUT + 2 * I_WO + I_KVD + I_KVU + I_DQ + I_UQ);
        for (int j = j0; j < j1; ++j) {
            const int it = gw + NGW * j; if (it >= NITEMS) break;
            int r = it;
            if (r < NFM * I_FFIN) { const int w = W0 + r / I_FFIN, layer = w >> 1, which = w & 1; r -= (w - W0) * I_FFIN;
                conv_item<MAP_SWIGLU>((which ? KARG(6) : KARG(2)) + (size_t)layer * 1024 * 5632, 1024, 5632, 5632, WPTR(WO_FFIN0) + (size_t)w * (W_FFIN / 2), (which ? KARG(5) : KARG(1)) + layer * 1024, r, lane); continue; }
            r -= NFM * I_FFIN;
            if (r < NFM * I_FFOUT) { const int w = W0 + r / I_FFOUT, layer = w >> 1, which = w & 1; r -= (w - W0) * I_FFOUT;
                conv_item<MAP_ID>((which ? KARG(7) : KARG(3)) + (size_t)layer * 2816 * 1024, 2816, 1024, 1024, WPTR(WO_FFOUT0) + (size_t)w * (W_FFOUT / 2), nullptr, r, lane); continue; }
            r -= NFM * I_FFOUT;
            if (PASS == 0) {
                conv_item<MAP_ID>(KARG(8), 1024, 3072, 3072, WPTR(WO_QKV), KARG(4), r, lane);
            } else {
                if (r < I_WO) { conv_item<MAP_ID>(KARG(10), 1024, 1024, 1024, WPTR(WO_AWO), nullptr, r, lane); continue; } r -= I_WO;
                if (r < I_WO) { conv_item<MAP_ID>(KARG(18), 1024, 1024, 1024, WPTR(WO_BWO), nullptr, r, lane); continue; } r -= I_WO;
                if (r < I_KVD) { conv_item<MAP_KVDOWN>(KARG(12), 1024, 320, 512, WPTR(WO_KVD), KARG(11), r, lane); continue; } r -= I_KVD;
                if (r < I_KVU) { conv_item<MAP_ID>(KARG(14), 256, 2048, 2048, WPTR(WO_KVU), KARG(13), r, lane); continue; } r -= I_KVU;
                if (r < I_DQ) { conv_item<MAP_ID>(KARG(15), 1024, 768, 768, WPTR(WO_DQ), KARG(4) + 1024, r, lane); continue; } r -= I_DQ;
                conv_item<MAP_UQ>(KARG(17), 768, 1536, 1536, WPTR(WO_UQ), KARG(16), r, lane);
            }
        }
}
__device__ __forceinline__ void prologue_phase(LAS unsigned char* lds, int tid, int lane, int wave, int G, int bx, int gw, int NGW) {
        convert_weights<0>(lane, gw, NGW);
        { const float* x = KARG(0); bf16* hb = BPTR(WS_HB); float* ssq = SSQ; float* rope = ROPE;
        for (int m = gw; m < M; m += NGW) {
            const f32x4* xr = (const f32x4*)(x + (size_t)m * D) + lane; f32x4 v[4]; float s = 0.f;
#pragma unroll
            for (int j = 0; j < 4; ++j) { v[j] = __builtin_nontemporal_load(xr + 64 * j); s += pg8::sq4(v[j]); }
            s = wave_sum(s);
            u32x2* o8 = (u32x2*)(hb + (size_t)m * D) + lane;
#pragma unroll
            for (int j = 0; j < 4; ++j) { u32x2 w; w.x = pk2(v[j][0], v[j][1]); w.y = pk2(v[j][2], v[j][3]); o8[64 * j] = w; }
            if (lane == 0) ssq[m] = s;
        }
        for (int i = bx * NTHREADS + tid; i < 8 * M; i += G * NTHREADS) ssq[M + i] = 0.f;
        for (int i = bx * NTHREADS + tid; i < 2048 * 32; i += G * NTHREADS) { const int pos = i >> 5, j = i & 31;
            const float freq = powf(10000.0f, -(float)j / 32.0f); const float ang = (float)pos * freq; rope[2 * i] = cosf(ang); rope[2 * i + 1] = sinf(ang); }
        }
        __syncthreads();
    }
#ifndef PROBE_PRO
#define PROBE_PRO
#endif
__global__ void __launch_bounds__(NTHREADS, 2) yoco_fwd(Args args) {
    extern __shared__ __attribute__((aligned(16))) unsigned char lds_raw[];
    LAS unsigned char* lds = (LAS unsigned char*)lds_raw;
    cg::grid_group grid = cg::this_grid();
    const int tid = threadIdx.x, lane = tid & 63, wave = __builtin_amdgcn_readfirstlane(tid >> 6);
    const int G = gridDim.x, bx = blockIdx.x;
    for (int u = tid; u < 64; u += NTHREADS) ((LAS unsigned*)(lds + MISC_OFF))[u] = 0u;
    __syncthreads();
    XcdBarrier bar = xcd_barrier_post((unsigned*)((unsigned char*)karg_ptr(21) + WS_CTL), (volatile LAS unsigned*)(lds + MISC_OFF));
    const int gw = bx * NWAVES + wave, NGW = G * NWAVES;
    const int lo = args.ph_lo, hi = args.ph_hi, use_cg = args.use_cg;
#define IN(k) (lo <= (k) && (k) < hi)
#define SEAM(k) do { if (IN(k) && IN((k) + 1)) { if (use_cg) grid.sync(); else xcd_barrier(bar); } } while (0)
    constexpr float C2A = 0.125f * 1.4426950408889634f;
    constexpr float C2B = 0.07216878364870322f * 1.4426950408889634f;

    if (IN(0)) { prologue_phase(lds, tid, lane, wave, G, bx, gw, NGW); PROBE_PRO }
    SEAM(0);
#define GEMM_PHASE(MODE, Aptr, Bptr, NN, KK, EPI) do { pg8::Gemm g_{Aptr, Bptr, M, NN, KK}; pg8::StaticOrder S_; S_.init(M, NN, G, bx); \
        pg8::gemm_phase<pg8::Epi<MODE>, pg8::StaticOrder, true, true>(lds, g_, S_, EPI); } while (0)
#define FFN_IN(kssq, widx) do { pg8::Epi<pg8::EM_SWIGLU> E{SSQ + (size_t)(kssq) * M, i1024, BPTR(WS_ACT), nullptr, nullptr, nullptr, nullptr, nullptr, 1.f, nullptr}; \
        GEMM_PHASE(pg8::EM_SWIGLU, BPTR(WS_HB), WPTR(WO_FFIN0 + (widx) * W_FFIN), 5632, 1024, E); } while (0)
#define FFN_OUT(MODE, HOLD, kssq, widx) do { pg8::Epi<MODE> E{nullptr, 0.f, BPTR(WS_HB), nullptr, nullptr, HOLD, HRES, SSQ + (size_t)(kssq) * M, 0.5f, nullptr}; \
        GEMM_PHASE(MODE, BPTR(WS_ACT), WPTR(WO_FFOUT0 + (widx) * W_FFOUT), 1024, 2816, E); } while (0)
#define WO_PROJ(Aoff, Woff, kssq) do { pg8::Epi<pg8::EM_RES> E{nullptr, 0.f, BPTR(WS_HB), nullptr, nullptr, nullptr, nullptr, SSQ + (size_t)(kssq) * M, 1.0f, nullptr}; \
        GEMM_PHASE(pg8::EM_RES, BPTR(Aoff), WPTR(Woff), 1024, 1024, E); } while (0)
    const float i1024 = 1.0f / 1024.0f;
    if (IN(1)) FFN_IN(0, 0);
    SEAM(1);
    if (IN(2)) FFN_OUT(pg8::EM_RES, nullptr, 1, 0);
    SEAM(2);
    if (IN(3)) { pg8::Epi<pg8::EM_QKV> E{SSQ + 1 * M, i1024, BPTR(WS_Q), nullptr, nullptr, nullptr, nullptr, nullptr, C2A, nullptr}; GEMM_PHASE(pg8::EM_QKV, BPTR(WS_HB), WPTR(WO_QKV), 3072, 1024, E); }
    SEAM(3);
    if (IN(4)) { attn_phase<0, 1>(lds, G, bx, BPTR(WS_Q), nullptr, BPTR(WS_K), nullptr, BPTR(WS_V), BPTR(WS_Q), KARG(9)); }
    SEAM(4);
    if (IN(5)) WO_PROJ(WS_Q, WO_AWO, 2);
    SEAM(5);
    if (IN(6)) FFN_IN(2, 1);
    SEAM(6);
    if (IN(7)) FFN_OUT(pg8::EM_RES, nullptr, 3, 1);
    SEAM(7);
    if (IN(8)) {
        { pg8::Epi<pg8::EM_KVDOWN> E{SSQ + 3 * M, i1024, BPTR(WS_CKV), BPTR(WS_KR), nullptr, nullptr, nullptr, SSQ + 4 * M, 1.f, ROPE}; GEMM_PHASE(pg8::EM_KVDOWN, BPTR(WS_HB), WPTR(WO_KVD), 512, 1024, E); }
        FFN_IN(3, 2);
    }
    SEAM(8);
    if (IN(9)) {
        { pg8::Epi<pg8::EM_KVUP> E{SSQ + 4 * M, 1.0f / 256.0f, BPTR(WS_KN), BPTR(WS_VB), nullptr, nullptr, nullptr, nullptr, 1.f, nullptr}; GEMM_PHASE(pg8::EM_KVUP, BPTR(WS_CKV), WPTR(WO_KVU), 2048, 256, E); }
        FFN_OUT(pg8::EM_RES, nullptr, 5, 2);
    }
    SEAM(9);
    if (IN(10)) { pg8::Epi<pg8::EM_DQ> E{SSQ + 5 * M, i1024, BPTR(WS_CQ), nullptr, nullptr, nullptr, nullptr, SSQ + 6 * M, 1.f, nullptr}; GEMM_PHASE(pg8::EM_DQ, BPTR(WS_HB), WPTR(WO_DQ), 768, 1024, E); }
    SEAM(10);
    if (IN(11)) { pg8::Epi<pg8::EM_UQ> E{SSQ + 6 * M, 1.0f / 768.0f, BPTR(WS_QN), BPTR(WS_QR), nullptr, nullptr, nullptr, nullptr, C2B, ROPE}; GEMM_PHASE(pg8::EM_UQ, BPTR(WS_CQ), WPTR(WO_UQ), 1536, 768, E); }
    SEAM(11);
    if (IN(12)) attn_phase<1>(lds, G, bx, BPTR(WS_QN), BPTR(WS_QR), BPTR(WS_KN), BPTR(WS_KR), BPTR(WS_VB), BPTR(WS_QN), nullptr);
    SEAM(12);
    if (IN(13)) WO_PROJ(WS_QN, WO_BWO, 7);
    SEAM(13);
    if (IN(14)) FFN_IN(7, 3);
    SEAM(14);
    if (IN(15)) FFN_OUT(pg8::EM_RES_F, nullptr, 8, 3);
    SEAM(15);
    if (IN(16)) {
        float* hres = HRES; const float* ssq = SSQ; const float* final_norm = KARG(19);
        for (int m = gw; m < M; m += NGW) {
            const float rs = __builtin_amdgcn_rsqf(ssq[8 * M + m] * i1024 + pg8::RMS_EPS);
            f32x4* xr = (f32x4*)(hres + (size_t)m * D) + lane; const f32x4* gr = (const f32x4*)final_norm + lane;
#pragma unroll
            for (int j = 0; j < 4; ++j) { const f32x4 v = xr[64 * j], g = gr[64 * j]; __builtin_nontemporal_store(v * rs * g, xr + 64 * j); }
        }
    }
#undef IN
#undef SEAM
}

#ifndef MK_MULTI
#define MK_MULTI 0
#endif
extern "C" void kernel_launch(void* const* d_in, const int* in_sizes, int n_in, void* d_out, int out_size, void* d_ws, size_t ws_size, hipStream_t stream) {
    static int grid = 0;
    if (grid == 0) {
        int dev = 0, cus = 0, per_cu = 0;
        hipGetDevice(&dev);
        hipDeviceGetAttribute(&cus, hipDeviceAttributeMultiprocessorCount, dev);
        hipFuncSetAttribute((const void*)yoco_fwd, hipFuncAttributeMaxDynamicSharedMemorySize, LDS_BYTES);
        hipOccupancyMaxActiveBlocksPerMultiprocessor(&per_cu, (const void*)yoco_fwd, NTHREADS, LDS_BYTES);
        if (per_cu < 1) per_cu = 1;
        grid = cus * 1;
        if (n_in != 20 || ws_size < WS_END) { fprintf(stderr, "kernel_launch: unexpected n_in %d / ws_size %zu (need %zu)\n", n_in, ws_size, (size_t)WS_END); }
        (void)hipGetLastError();
    }
    (void)hipMemsetAsync((char*)d_ws + WS_CTL, 0, CTL_BYTES, stream);
    Args a{};
    for (int i = 0; i < 20; ++i) a.in[i] = (const float*)d_in[i];
    a.out = (float*)d_out; a.ws = (unsigned char*)d_ws;
#if MK_MULTI
    for (int p = 0; p < 17; ++p) { a.ph_lo = p; a.ph_hi = p + 1; void* kargs[] = {&a};
        hipLaunchCooperativeKernel((const void*)yoco_fwd, dim3(grid), dim3(NTHREADS), kargs, LDS_BYTES, stream); }
#else
    a.ph_lo = 0; a.ph_hi = 17; void* kargs[] = {&a};
    hipError_t e = hipLaunchCooperativeKernel((const void*)yoco_fwd, dim3(grid), dim3(NTHREADS), kargs, LDS_BYTES, stream);
    if (e != hipSuccess) fprintf(stderr, "cooperative launch failed: %s (grid %d)\n", hipGetErrorString(e), grid);
#endif
}
```

```cpp
#include <hip/hip_runtime.h>
namespace pg8 {
#define PG8_LAS __attribute__((address_space(3)))
typedef unsigned short bf16_t;
typedef short bf16x8 __attribute__((ext_vector_type(8)));
typedef float f32x4 __attribute__((ext_vector_type(4)));
typedef unsigned u32x4 __attribute__((ext_vector_type(4)));
constexpr int BM = 256, BK = 64, HALF = 128, HTB = HALF * BK * 2  , STAGE_BYTES = 8 * HTB, NXCD = 8, WGM = 8;

__host__ __device__ __forceinline__ int lds_byte(int r, int c) { const int st = (r >> 4) * 2 + (c >> 5), rr = r & 15, cc = c & 31, ob = rr * 64 + cc * 2; return st * 1024 + (ob ^ (((ob >> 9) & 1) << 5)); }
__host__ __device__ __forceinline__ void stage_rc(int b, int& R, int& C) { const int st = b / 1024, sb = b % 1024, swz = sb ^ (((sb >> 9) & 1) << 5); R = (st >> 1) * 16 + swz / 64; C = (st & 1) * 32 + (swz % 64) / 2; }
__host__ __device__ __forceinline__ int perm32(int rho) { const int n = rho >> 4, i = rho & 15; return 8 * (i >> 2) + 4 * n + (i & 3); }

struct Unit { int pm, pn; };
struct Gemm { const bf16_t* A; const bf16_t* Bt; int M, N, K; };

struct StaticOrder {
    int nM, nN, nwg, G, c;
    __host__ __device__ void init(int M, int N, int G_, int c_) { nM = M / BM; nN = N / BM; nwg = nM * nN; G = G_; c = c_; }
    __host__ __device__ bool next(int i, Unit& u) const {
        const long L = (long)i * G + c; if (L >= nwg) return false;
        int wgid = (int)L; { const int q = nwg / NXCD, r = nwg % NXCD, xcd = wgid % NXCD, off = wgid / NXCD; wgid = (xcd < r ? xcd * (q + 1) : r * (q + 1) + (xcd - r) * q) + off; }
        const int nig = WGM * nN, gid = wgid / nig, fm = gid * WGM, gsz = (nM - fm) < WGM ? (nM - fm) : WGM;
        u.pm = fm + ((wgid % nig) % gsz); u.pn = (wgid % nig) / gsz; return true;
    }
    __device__ __forceinline__ void a_ready(const Unit&) const {}
    __device__ __forceinline__ void done(const Unit&) const {}
};


struct KvuOrder {
    int c;
    __device__ bool next(int i, Unit& u) const { int idx; if (c < 128) { if (i >= 3) return false; idx = 3 * c + i; } else { if (i >= 5) return false; idx = 384 + 5 * (c - 128) + i; } u.pm = idx >> 3; u.pn = idx & 7; return true; }
    __device__ __forceinline__ void a_ready(const Unit&) const {}
    __device__ __forceinline__ void done(const Unit&) const {}
};
__device__ __forceinline__ unsigned cvt_pk_bf16(float lo, float hi) {
    typedef float f2_t __attribute__((ext_vector_type(2))); typedef __bf16 b2_t __attribute__((ext_vector_type(2)));
    f2_t v = {lo, hi}; b2_t b = __builtin_convertvector(v, b2_t); return __builtin_bit_cast(unsigned, b);
}
__device__ __forceinline__ u32x4 pack8(const f32x4 a, const f32x4 b) { u32x4 w; w.x = cvt_pk_bf16(a[0], a[1]); w.y = cvt_pk_bf16(a[2], a[3]); w.z = cvt_pk_bf16(b[0], b[1]); w.w = cvt_pk_bf16(b[2], b[3]); return w; }
__device__ __forceinline__ float sq4(const f32x4 a) { return (a[0] * a[0] + a[1] * a[1]) + (a[2] * a[2] + a[3] * a[3]); }
__device__ __forceinline__ float silu_mul(float g, float u) { return g * __builtin_amdgcn_rcpf(1.0f + __builtin_amdgcn_exp2f(-1.4426950408889634f * g)) * u; }

__device__ __forceinline__ f32x4 swiglu4(const f32x4 g, const f32x4 u, float rs) {
    const f32x4 t = g * (rs * -1.4426950408889634f); f32x4 e;
#pragma unroll
    for (int i = 0; i < 4; ++i) e[i] = __builtin_amdgcn_exp2f(t[i]);
    e = e + 1.0f; f32x4 r;
#pragma unroll
    for (int i = 0; i < 4; ++i) r[i] = __builtin_amdgcn_rcpf(e[i]);
    return (g * u) * (r * (rs * rs));
}
enum { EM_SWIGLU = 0, EM_RES = 1, EM_QKV = 2, EM_KVDOWN = 3, EM_KVUP = 4, EM_DQ = 5, EM_UQ = 6, EM_RES_X = 7, EM_RES_F = 8 };
constexpr float RMS_EPS = 1e-6f;
template <int MODE> struct Epi {
    static constexpr bool PERM = true, AFTER_DRAIN = false;
    const float* ssq_in; float inv_n;
    bf16_t* o0; bf16_t* o1; bf16_t* o2;
    const float* hold; float* hnew;
    float* ssq_out;
    float scale;
    const float* rope;
    __device__ __forceinline__ void operator()(const f32x4 (&acc)[2][2][4][2], const Unit& u, int wr, int wc, int fr, int fq) const {
        const int cb = wc * 32 + 8 * fq;
        if (MODE == EM_RES || MODE == EM_RES_X || MODE == EM_RES_F) {
            if (MODE == EM_RES_X) {
#pragma unroll
                for (int ai = 0; ai < 2; ++ai) {
                    f32x4 pre[4][2][2];
#pragma unroll
                    for (int m = 0; m < 4; ++m)
#pragma unroll
                        for (int bj = 0; bj < 2; ++bj) { const size_t off = (size_t)(u.pm * BM + ai * HALF + wr * 64 + m * 16 + fr) * 1024 + u.pn * BM + bj * HALF + cb;
                            pre[m][bj][0] = *(const f32x4*)(hold + off); pre[m][bj][1] = *(const f32x4*)(hold + off + 4); }
#pragma unroll
                    for (int m = 0; m < 4; ++m) { const int row = u.pm * BM + ai * HALF + wr * 64 + m * 16 + fr; float s = 0.f;
#pragma unroll
                        for (int bj = 0; bj < 2; ++bj) { const size_t off = (size_t)row * 1024 + u.pn * BM + bj * HALF + cb;
                            const f32x4 n0 = pre[m][bj][0] + acc[ai][bj][m][0] * scale, n1 = pre[m][bj][1] + acc[ai][bj][m][1] * scale;
                            *(u32x4*)(o0 + off) = pack8(n0, n1); s += sq4(n0) + sq4(n1); }
                        s += __shfl_xor(s, 16); s += __shfl_xor(s, 32);
                        if (fq == 0) unsafeAtomicAdd(ssq_out + row, s); }
                }
                return;
            }
            u32x4 prw[2][4][2];
#pragma unroll
            for (int ai = 0; ai < 2; ++ai)
#pragma unroll
                for (int m = 0; m < 4; ++m)
#pragma unroll
                    for (int bj = 0; bj < 2; ++bj) prw[ai][m][bj] = *(const u32x4*)(o0 + (size_t)(u.pm * BM + ai * HALF + wr * 64 + m * 16 + fr) * 1024 + u.pn * BM + bj * HALF + cb);
#pragma unroll
            for (int ai = 0; ai < 2; ++ai)
#pragma unroll
                for (int m = 0; m < 4; ++m) { const int row = u.pm * BM + ai * HALF + wr * 64 + m * 16 + fr; float s = 0.f;
#pragma unroll
                    for (int bj = 0; bj < 2; ++bj) { const size_t off = (size_t)row * 1024 + u.pn * BM + bj * HALF + cb; const u32x4 w = prw[ai][m][bj];
                        const f32x4 p0 = (f32x4){__builtin_bit_cast(float, w.x << 16), __builtin_bit_cast(float, w.x & 0xffff0000u), __builtin_bit_cast(float, w.y << 16), __builtin_bit_cast(float, w.y & 0xffff0000u)};
                        const f32x4 p1 = (f32x4){__builtin_bit_cast(float, w.z << 16), __builtin_bit_cast(float, w.z & 0xffff0000u), __builtin_bit_cast(float, w.w << 16), __builtin_bit_cast(float, w.w & 0xffff0000u)};
                        const f32x4 n0 = p0 + acc[ai][bj][m][0] * scale, n1 = p1 + acc[ai][bj][m][1] * scale;
                        if (MODE == EM_RES_F) { *(f32x4*)(hnew + off) = n0; *(f32x4*)(hnew + off + 4) = n1; }
                        else *(u32x4*)(o0 + off) = pack8(n0, n1);
                        s += sq4(n0) + sq4(n1); }
                    s += __shfl_xor(s, 16); s += __shfl_xor(s, 32);
                    if (fq == 0) unsafeAtomicAdd(ssq_out + row, s); }
            return;
        }
#pragma unroll
        for (int ai = 0; ai < 2; ++ai)
#pragma unroll
            for (int m = 0; m < 4; ++m) {
                const int row = u.pm * BM + ai * HALF + wr * 64 + m * 16 + fr;
                float rs = 1.f;
                rs = __builtin_amdgcn_rsqf(ssq_in[row] * inv_n + RMS_EPS);
                if (MODE == EM_SWIGLU) {
                    f32x4 a0, a1;
#pragma unroll
                    for (int e = 0; e < 1; ++e) { a0 = swiglu4(acc[ai][0][m][0], acc[ai][1][m][0], rs); a1 = swiglu4(acc[ai][0][m][1], acc[ai][1][m][1], rs); }
                    *(u32x4*)(o0 + (size_t)row * 2816 + u.pn * 128 + cb) = pack8(a0, a1);
                } else if (MODE == EM_QKV) {
                    const int t = u.pn >> 2; bf16_t* base = o0 + (size_t)t * ((size_t)32768 * 1024); const float sc = (t == 0) ? rs * scale : rs;
#pragma unroll
                    for (int bj = 0; bj < 2; ++bj)
                        *(u32x4*)(base + (size_t)row * 1024 + (u.pn & 3) * BM + bj * HALF + cb) = pack8(acc[ai][bj][m][0] * sc, acc[ai][bj][m][1] * sc);
                } else if (MODE == EM_KVDOWN) {
                    if (u.pn == 0) {
                        float s = 0.f;
#pragma unroll
                        for (int bj = 0; bj < 2; ++bj) { const f32x4 v0 = acc[ai][bj][m][0] * rs, v1 = acc[ai][bj][m][1] * rs; s += sq4(v0) + sq4(v1);
                            *(u32x4*)(o0 + (size_t)row * 256 + bj * HALF + cb) = pack8(v0, v1); }
                        s += __shfl_xor(s, 16); s += __shfl_xor(s, 32);
                        if (fq == 0) unsafeAtomicAdd(ssq_out + row, s);
                    } else if (wc == 0) {
                        const int pos = row & 2047; const float* rp = rope + ((size_t)pos * 32 + 8 * fq) * 2;
                        f32x4 y0a, y0b, y1a, y1b;
#pragma unroll
                        for (int e = 0; e < 4; ++e) {
                            { const float x1 = rs * acc[ai][0][m][0][e], x2 = rs * acc[ai][1][m][0][e], c = rp[2 * e], sn = rp[2 * e + 1]; y0a[e] = x1 * c - x2 * sn; y1a[e] = x2 * c + x1 * sn; }
                            { const float x1 = rs * acc[ai][0][m][1][e], x2 = rs * acc[ai][1][m][1][e], c = rp[8 + 2 * e], sn = rp[8 + 2 * e + 1]; y0b[e] = x1 * c - x2 * sn; y1b[e] = x2 * c + x1 * sn; }
                        }
                        *(u32x4*)(o1 + (size_t)row * 64 + 8 * fq) = pack8(y0a, y0b);
                        *(u32x4*)(o1 + (size_t)row * 64 + 32 + 8 * fq) = pack8(y1a, y1b);
                    }
                } else if (MODE == EM_KVUP) {
                    *(u32x4*)(o0 + (size_t)row * 1024 + u.pn * 128 + cb) = pack8(acc[ai][0][m][0] * rs, acc[ai][0][m][1] * rs);
                    *(u32x4*)(o1 + (size_t)row * 1024 + u.pn * 128 + cb) = pack8(acc[ai][1][m][0] * rs, acc[ai][1][m][1] * rs);
                } else if (MODE == EM_DQ) {
                    float s = 0.f;
#pragma unroll
                    for (int bj = 0; bj < 2; ++bj) { const f32x4 v0 = acc[ai][bj][m][0] * rs, v1 = acc[ai][bj][m][1] * rs; s += sq4(v0) + sq4(v1);
                        *(u32x4*)(o0 + (size_t)row * 768 + u.pn * BM + bj * HALF + cb) = pack8(v0, v1); }
                    s += __shfl_xor(s, 16); s += __shfl_xor(s, 32);
                    if (fq == 0) unsafeAtomicAdd(ssq_out + row, s);
                } else if (MODE == EM_UQ) {
                    const float sc = rs * scale;
                    if (u.pn < 4) {
#pragma unroll
                        for (int bj = 0; bj < 2; ++bj)
                            *(u32x4*)(o0 + (size_t)row * 1024 + u.pn * BM + bj * HALF + cb) = pack8(acc[ai][bj][m][0] * sc, acc[ai][bj][m][1] * sc);
                    } else {
                        const int head = (u.pn - 4) * 4 + wc; const int pos = row & 2047; const float* rp = rope + ((size_t)pos * 32 + 8 * fq) * 2;
                        f32x4 y0a, y0b, y1a, y1b;
#pragma unroll
                        for (int e = 0; e < 4; ++e) {
                            { const float x1 = sc * acc[ai][0][m][0][e], x2 = sc * acc[ai][1][m][0][e], c = rp[2 * e], sn = rp[2 * e + 1]; y0a[e] = x1 * c - x2 * sn; y1a[e] = x2 * c + x1 * sn; }
                            { const float x1 = sc * acc[ai][0][m][1][e], x2 = sc * acc[ai][1][m][1][e], c = rp[8 + 2 * e], sn = rp[8 + 2 * e + 1]; y0b[e] = x1 * c - x2 * sn; y1b[e] = x2 * c + x1 * sn; }
                        }
                        *(u32x4*)(o1 + (size_t)row * 512 + head * 64 + 8 * fq) = pack8(y0a, y0b);
                        *(u32x4*)(o1 + (size_t)row * 512 + head * 64 + 32 + 8 * fq) = pack8(y1a, y1b);
                    }
                }
            }
    }
};

template <class Epi, class Sched, bool ALIGN_EPI = false, bool SP2 = false>
__device__ __forceinline__ void gemm_phase(PG8_LAS unsigned char* lds, const Gemm g, const Sched& S, const Epi& E) {
    int tid_ = threadIdx.x; asm volatile("" : "+v"(tid_));
    const int tid = tid_, wid = __builtin_amdgcn_readfirstlane(tid >> 6), lane = tid & 63, wr = wid >> 2, wc = wid & 3, fr = lane & 15, fq = lane >> 4;
    const int K = g.K, nt = K / BK;
    unsigned voffA[2], voffB[2];
#pragma unroll
    for (int i = 0; i < 2; ++i) { int R, C; stage_rc(tid * 16 + i * 8192, R, C); const int Rb = Epi::PERM ? ((R & ~31) + perm32(R & 31)) : R;
        voffA[i] = (unsigned)(R * K + C) * 2u; voffB[i] = (unsigned)(Rb * K + C) * 2u; }
    const size_t kstep = (size_t)(BK * 2);
    const size_t hstep = (size_t)HALF * K * 2;
    const size_t tstep = 2 * hstep;
    const unsigned ldsw = (unsigned)wid * 1024u;
    const int aoff = lds_byte(wr * 64 + fr, fq * 8), boff = lds_byte(wc * 32 + fr, fq * 8);
#define PG8_SA(b, h) (((b) * 2 + (h)) * HTB)
#define PG8_SB(b, h) ((4 + (b) * 2 + (h)) * HTB)
#define PG8_STAGE(bufoff, gbase, voff) do { _Pragma("unroll") for (int _i = 0; _i < 2; ++_i) \
        __builtin_amdgcn_global_load_lds((const unsigned*)((const char*)(gbase) + (voff)[_i]), (PG8_LAS unsigned*)(lds + (bufoff) + ldsw + _i * 8192), 16, 0, 0); } while (0)
#define PG8_LDA(dst, b, h) do { _Pragma("unroll") for (int m = 0; m < 4; ++m) _Pragma("unroll") for (int k = 0; k < 2; ++k) dst[m][k] = *(const PG8_LAS bf16x8*)(lds + PG8_SA(b, h) + aoff + m * 2048 + k * 1024); } while (0)
#define PG8_LDB(dst, b, h) do { _Pragma("unroll") for (int n = 0; n < 2; ++n) _Pragma("unroll") for (int k = 0; k < 2; ++k) dst[n][k] = *(const PG8_LAS bf16x8*)(lds + PG8_SB(b, h) + boff + n * 2048 + k * 1024); } while (0)
#define PG8_MMA(ai, bj, At, Bt) do { __builtin_amdgcn_s_setprio(1); _Pragma("unroll") for (int m = 0; m < 4; ++m) _Pragma("unroll") for (int n = 0; n < 2; ++n) _Pragma("unroll") for (int k = 0; k < 2; ++k) \
        acc[ai][bj][m][n] = __builtin_amdgcn_mfma_f32_16x16x32_bf16(Bt[n][k], At[m][k], acc[ai][bj][m][n], 0, 0, 0); __builtin_amdgcn_s_setprio(0); } while (0)
#define PG8_WAIT_V(n) asm volatile("s_waitcnt vmcnt(" #n ")" ::: "memory")
#define PG8_WAIT_L(n) asm volatile("s_waitcnt lgkmcnt(" #n ")" ::: "memory")
#define PG8_BAR __builtin_amdgcn_s_barrier()
#define PG8_SCHED __builtin_amdgcn_sched_barrier(0)
    Unit cur, nxt; int ui = 0;
    if (!S.next(0, cur)) return;
    f32x4 acc[2][2][4][2];
#pragma unroll
    for (int a = 0; a < 2; ++a)
#pragma unroll
        for (int b = 0; b < 2; ++b)
#pragma unroll
            for (int m = 0; m < 4; ++m)
#pragma unroll
                for (int n = 0; n < 2; ++n) acc[a][b][m][n] = (f32x4){0.f, 0.f, 0.f, 0.f};
    bf16x8 At[4][2], B0[2][2], B1[2][2];
    const char* cA = (const char*)g.A + (size_t)cur.pm * tstep; const char* cB = (const char*)g.Bt + (size_t)cur.pn * tstep;
    S.a_ready(cur);
    if constexpr (SP2) {
        PG8_STAGE(PG8_SB(0, 0), cB, voffB); PG8_STAGE(PG8_SB(0, 1), cB + hstep, voffB); PG8_STAGE(PG8_SA(0, 0), cA, voffA); PG8_STAGE(PG8_SA(0, 1), cA + hstep, voffA);
        if (wr == 1) PG8_BAR;
        PG8_WAIT_V(2); PG8_BAR;
        PG8_STAGE(PG8_SB(1, 0), cB + kstep, voffB); PG8_STAGE(PG8_SA(1, 0), cA + kstep, voffA); PG8_STAGE(PG8_SB(1, 1), cB + hstep + kstep, voffB);
        PG8_WAIT_V(6); PG8_BAR;
    } else {
        PG8_STAGE(PG8_SB(0, 0), cB, voffB); PG8_STAGE(PG8_SA(0, 0), cA, voffA); PG8_STAGE(PG8_SB(0, 1), cB + hstep, voffB); PG8_STAGE(PG8_SA(0, 1), cA + hstep, voffA);
        if (wr == 1) PG8_BAR;
        PG8_WAIT_V(4); PG8_BAR;
        PG8_STAGE(PG8_SB(1, 0), cB + kstep, voffB); PG8_STAGE(PG8_SA(1, 0), cA + kstep, voffA); PG8_STAGE(PG8_SB(1, 1), cB + hstep + kstep, voffB);
        PG8_WAIT_V(6); PG8_BAR;
    }
    for (;;) {
        const bool has_next = S.next(ui + 1, nxt);
        const char* nA = has_next ? (const char*)g.A + (size_t)nxt.pm * tstep : cA; const char* nB = has_next ? (const char*)g.Bt + (size_t)nxt.pn * tstep : cB;
        for (int t = 0; t < nt; t += 2) {
            const bool last = (t == nt - 2);
            const char* a1 = cA + (size_t)(t + 1) * kstep;
            const char* a2 = last ? nA : cA + (size_t)(t + 2) * kstep; const char* b2 = last ? nB : cB + (size_t)(t + 2) * kstep;
            const char* a3 = a2 + kstep; const char* b3 = b2 + kstep;
            if (last && has_next) S.a_ready(nxt);
            if constexpr (SP2) {
            PG8_LDB(B0, 0, 0); PG8_LDB(B1, 0, 1); PG8_SCHED; PG8_LDA(At, 0, 0); PG8_STAGE(PG8_SA(1, 1), a1 + hstep, voffA);
            PG8_WAIT_V(8); PG8_WAIT_L(0); PG8_BAR; PG8_MMA(0, 0, At, B0); PG8_MMA(0, 1, At, B1); PG8_BAR; PG8_SCHED;
            PG8_LDA(At, 0, 1); PG8_STAGE(PG8_SB(0, 0), b2, voffB); PG8_STAGE(PG8_SB(0, 1), b2 + hstep, voffB); PG8_STAGE(PG8_SA(0, 0), a2, voffA);
            PG8_WAIT_V(8); PG8_WAIT_L(0); PG8_BAR; PG8_MMA(1, 0, At, B0); PG8_MMA(1, 1, At, B1); PG8_BAR; PG8_SCHED;
            PG8_LDB(B0, 1, 0); PG8_LDB(B1, 1, 1); PG8_SCHED; PG8_LDA(At, 1, 0); PG8_STAGE(PG8_SA(0, 1), a2 + hstep, voffA);
            PG8_WAIT_V(8); PG8_WAIT_L(0); PG8_BAR; PG8_MMA(0, 0, At, B0); PG8_MMA(0, 1, At, B1); PG8_BAR; PG8_SCHED;
            PG8_LDA(At, 1, 1); PG8_STAGE(PG8_SB(1, 0), b3, voffB); PG8_STAGE(PG8_SB(1, 1), b3 + hstep, voffB); PG8_STAGE(PG8_SA(1, 0), a3, voffA);
            PG8_WAIT_V(8); PG8_WAIT_L(0); PG8_BAR; PG8_MMA(1, 0, At, B0); PG8_MMA(1, 1, At, B1); PG8_BAR; PG8_SCHED;
            } else {
            PG8_LDB(B0, 0, 0); PG8_SCHED; PG8_LDA(At, 0, 0); PG8_STAGE(PG8_SA(1, 1), a1 + hstep, voffA);
            PG8_WAIT_L(8); PG8_BAR; PG8_WAIT_L(0); PG8_MMA(0, 0, At, B0); PG8_BAR; PG8_SCHED;
            PG8_LDB(B1, 0, 1); PG8_STAGE(PG8_SB(0, 0), b2, voffB);
            PG8_BAR; PG8_WAIT_L(0); PG8_MMA(0, 1, At, B1); PG8_BAR;
            PG8_LDA(At, 0, 1); PG8_STAGE(PG8_SA(0, 0), a2, voffA);
            PG8_BAR; PG8_WAIT_L(0); PG8_MMA(1, 0, At, B0); PG8_BAR; PG8_SCHED;
            PG8_STAGE(PG8_SB(0, 1), b2 + hstep, voffB);
            PG8_WAIT_V(6); PG8_BAR; PG8_MMA(1, 1, At, B1); PG8_BAR;
            PG8_LDB(B0, 1, 0); PG8_SCHED; PG8_LDA(At, 1, 0); PG8_STAGE(PG8_SA(0, 1), a2 + hstep, voffA);
            PG8_WAIT_L(8); PG8_BAR; PG8_WAIT_L(0); PG8_MMA(0, 0, At, B0); PG8_BAR; PG8_SCHED;
            PG8_LDB(B1, 1, 1); PG8_STAGE(PG8_SB(1, 0), b3, voffB);
            PG8_BAR; PG8_WAIT_L(0); PG8_MMA(0, 1, At, B1); PG8_BAR;
            PG8_LDA(At, 1, 1); PG8_STAGE(PG8_SA(1, 0), a3, voffA);
            PG8_BAR; PG8_WAIT_L(0); PG8_MMA(1, 0, At, B0); PG8_BAR; PG8_SCHED;
            PG8_STAGE(PG8_SB(1, 1), b3 + hstep, voffB);
            PG8_WAIT_V(6); PG8_BAR; PG8_MMA(1, 1, At, B1); PG8_BAR;
            }
        }
        if constexpr (ALIGN_EPI) { if (wr == 0) PG8_BAR; }
        if constexpr (!Epi::AFTER_DRAIN) { E(acc, cur, wr, wc, fr, fq); S.done(cur); }
        if (!has_next) break;
#pragma unroll
        for (int a = 0; a < 2; ++a)
#pragma unroll
            for (int b = 0; b < 2; ++b)
#pragma unroll
                for (int m = 0; m < 4; ++m)
#pragma unroll
                    for (int n = 0; n < 2; ++n) acc[a][b][m][n] = (f32x4){0.f, 0.f, 0.f, 0.f};
        cur = nxt; cA = nA; cB = nB; ++ui;
        if constexpr (ALIGN_EPI) { if (wr == 1) PG8_BAR; }
    }
    PG8_WAIT_V(0);
    if constexpr (!ALIGN_EPI) { if (wr == 0) PG8_BAR; }
    PG8_BAR;
    if constexpr (Epi::AFTER_DRAIN) { E.fused(acc, cur, wr, wc, fr, fq, lds, wid, lane); S.done(cur); }
#undef PG8_SA
#undef PG8_SB
#undef PG8_STAGE
#undef PG8_LDA
#undef PG8_LDB
#undef PG8_MMA
#undef PG8_WAIT_V
#undef PG8_WAIT_L
#undef PG8_BAR
#undef PG8_SCHED
}
}

#include <hip/hip_cooperative_groups.h>
#include <cstdio>
#include <cstdint>
namespace cg = cooperative_groups;
#define LAS __attribute__((address_space(3)))
typedef unsigned short bf16;
typedef float f32x4 __attribute__((ext_vector_type(4)));
typedef float f32x16 __attribute__((ext_vector_type(16)));
typedef short bf16x8 __attribute__((ext_vector_type(8)));
typedef unsigned u32x4 __attribute__((ext_vector_type(4)));
typedef unsigned u32x2 __attribute__((ext_vector_type(2)));
typedef short s16x4 __attribute__((ext_vector_type(4)));

constexpr int NWAVES = 8, NTHREADS = 512;
constexpr int BATCH = 16, SEQ = 2048, D = 1024, M = BATCH * SEQ, FF = 2816;
constexpr int LDS_BYTES = 131072 + 256, MISC_OFF = 131072;
constexpr size_t MiB = 1u << 20;
constexpr size_t WS_SSQ = 0;
constexpr size_t WS_ROPE = 2 * MiB;
constexpr size_t WS_CTL = 3 * MiB, CTL_BYTES = 16384;
constexpr size_t WS_W = 4 * MiB;
constexpr size_t W_FFIN = (size_t)5632 * 1024 * 2, W_FFOUT = (size_t)1024 * 2816 * 2;
constexpr size_t WO_FFIN0 = 0, WO_FFOUT0 = WO_FFIN0 + 4 * W_FFIN;
constexpr size_t WO_QKV = WO_FFOUT0 + 4 * W_FFOUT, WO_AWO = WO_QKV + (size_t)3072 * 1024 * 2, WO_KVD = WO_AWO + (size_t)1024 * 1024 * 2;
constexpr size_t WO_KVU = WO_KVD + (size_t)512 * 1024 * 2, WO_DQ = WO_KVU + (size_t)2048 * 256 * 2, WO_UQ = WO_DQ + (size_t)768 * 1024 * 2;
constexpr size_t WO_BWO = WO_UQ + (size_t)1536 * 768 * 2, WO_END = WO_BWO + (size_t)1024 * 1024 * 2;
static_assert(WO_END <= 96 * MiB, "weights fit");
constexpr size_t WS_HB = 100 * MiB;
constexpr size_t WS_BIG = 164 * MiB;
constexpr size_t WS_ACT = WS_BIG, WS_Q = WS_BIG, WS_K = WS_BIG + 64 * MiB, WS_V = WS_BIG + 128 * MiB;
constexpr size_t WS_QN = WS_BIG, WS_QR = WS_BIG + 64 * MiB, WS_CQ = WS_BIG + 96 * MiB;
constexpr size_t WS_KN = 356 * MiB, WS_VB = WS_KN + 64 * MiB, WS_CKV = WS_VB + 64 * MiB, WS_KR = WS_CKV + 16 * MiB, WS_END = WS_KR + 4 * MiB;
static_assert(WS_END <= 512 * MiB, "ws map");

__device__ __forceinline__ unsigned f2bf(float f) { unsigned u = __builtin_bit_cast(unsigned, f); return (u + 0x7fffu + ((u >> 16) & 1u)) >> 16; }
__device__ __forceinline__ unsigned pk2(float lo, float hi) { return f2bf(lo) | (f2bf(hi) << 16); }
__device__ __forceinline__ float wave_sum(float v) {
#pragma unroll
    for (int o = 1; o < 64; o <<= 1) v += __shfl_xor(v, o);
    return v;
}

enum { MAP_ID = 0, MAP_SWIGLU = 1, MAP_KVDOWN = 2, MAP_UQ = 3 };
template <int MAP> __device__ __forceinline__ int map_col(int np) {
    if (MAP == MAP_ID) return np;
    if (MAP == MAP_SWIGLU) { const int t = np >> 8, rem = np & 255, half = rem >> 7, c = rem & 127; return half * 2816 + 128 * t + c; }
    if (MAP == MAP_KVDOWN) { if (np < 256) return np; const int rem = np - 256, half = rem >> 7, c = rem & 127; return c < 32 ? 256 + 32 * half + c : -1; }
    if (np < 1024) { const int t = np >> 8, bj = (np >> 7) & 1, c = np & 127; return (2 * t + bj) * 192 + c; }
    { const int rem = np - 1024, t = rem >> 8, half = (rem >> 7) & 1, c = rem & 127, head = t * 4 + (c >> 5); return head * 192 + 128 + 32 * half + (c & 31); }
}
template <int MAP> __device__ __forceinline__ void conv_item(const float* W, int K, int Nsrc, int NP, bf16* WT, const float* gain, int item, int lane) {
    const int nblk = NP / 128, kb0 = item / nblk, nb = item % nblk, k0 = 64 * kb0, n0 = 128 * nb;
    const int nq = lane & 31, kh = lane >> 5;
    const int s32 = map_col<MAP>(n0 + ((4 * nq) & ~31));
    const int src = s32 + ((4 * nq) & 31);
    bf16* dst = WT + (size_t)(n0 + 4 * nq) * K + k0 + 8 * kh;
    if (s32 < 0) {
#pragma unroll
        for (int kk = 0; kk < 4; ++kk)
#pragma unroll
            for (int c = 0; c < 4; ++c) *(u32x4*)(dst + (size_t)c * K + 16 * kk) = (u32x4){0u, 0u, 0u, 0u};
        return;
    }
#pragma unroll
    for (int kp = 0; kp < 2; ++kp) {
        f32x4 v[2][8]; f32x4 g0[2], g1[2];
#pragma unroll
        for (int k2 = 0; k2 < 2; ++k2) { const int kb = k0 + 16 * (2 * kp + k2) + 8 * kh;
#pragma unroll
            for (int j = 0; j < 8; ++j) v[k2][j] = __builtin_nontemporal_load((const f32x4*)(W + (size_t)(kb + j) * Nsrc + src));
            if (gain) { g0[k2] = *(const f32x4*)(gain + kb); g1[k2] = *(const f32x4*)(gain + kb + 4); } else { g0[k2] = (f32x4){1.f, 1.f, 1.f, 1.f}; g1[k2] = g0[k2]; } }
#pragma unroll
        for (int k2 = 0; k2 < 2; ++k2)
#pragma unroll
            for (int c = 0; c < 4; ++c) { u32x4 o;
                o.x = pk2(v[k2][0][c] * g0[k2][0], v[k2][1][c] * g0[k2][1]); o.y = pk2(v[k2][2][c] * g0[k2][2], v[k2][3][c] * g0[k2][3]);
                o.z = pk2(v[k2][4][c] * g1[k2][0], v[k2][5][c] * g1[k2][1]); o.w = pk2(v[k2][6][c] * g1[k2][2], v[k2][7][c] * g1[k2][3]);
                *(u32x4*)(dst + (size_t)c * K + 16 * (2 * kp + k2)) = o; }
    }
}

struct Args {
    const float* in[20]; float* out; unsigned char* ws; int ph_lo, ph_hi, use_cg, pad;
};

template <int PASS> __device__ __forceinline__ void convert_weights(int lane, int gw, int NGW, int j0 = 0, int j1 = 1 << 20);
template <int MLA, int CONV = 0> __device__ __forceinline__ void attn_phase(LAS unsigned char* lds, int G, int cwg,
        const bf16* Q0, const bf16* Q1, const bf16* K0, const bf16* K1, const bf16* V, bf16* O, const float* rel_table) {
    constexpr int DQK = MLA ? 192 : 64, DV = MLA ? 128 : 64, NH = MLA ? 8 : 16, NKS = DQK / 16, NDB = DV / 32;
    constexpr int KROW = DQK + 8, VROW = DV + 32;
    constexpr int KCH = DQK / 8, NKC = 64 * KCH / NTHREADS;
    constexpr int NVC = 64 * (DV / 8) / NTHREADS;
    LAS bf16* Ks = (LAS bf16*)lds;
    LAS bf16* Vt = (LAS bf16*)(lds + 64 * KROW * 2);
    LAS float* Bt = (LAS float*)(lds + 64 * KROW * 2 + 64 * VROW * 2);
    int tid_ = threadIdx.x; asm volatile("" : "+v"(tid_));
    const int tid = tid_, lane = tid & 63, wid = __builtin_amdgcn_readfirstlane(tid >> 6), r32 = lane & 31, hi = lane >> 5;
    const int nunits = BATCH * NH * 8;
    const int pi = 16 * (r32 >> 4) + 8 * ((r32 >> 2) & 1) + 4 * ((r32 >> 3) & 1) + (r32 & 3);
    for (int L = cwg; L < nunits; L += G) {
        int b, h, grp;
        if (MLA) { const int pair = L / (BATCH * NH), bh = L % (BATCH * NH); b = bh / NH; h = bh % NH; grp = (0x10235467 >> (4 * pair)) & 7; }
        else { grp = L / (BATCH * NH); const int bh = L % (BATCH * NH); b = bh / NH; h = bh % NH; }
        const int tok0 = b * SEQ;
        const int cq = 4 * grp + (wid >> 1);
        const int qrow = tok0 + 256 * grp + 32 * wid + r32;
        const int kc_lo = MLA ? 0 : ((4 * grp - 8) > 0 ? (4 * grp - 8) : 0), kc_hi = 4 * grp + 3;
        bf16x8 qf[NKS];
#pragma unroll
        for (int ks = 0; ks < NKS; ++ks) {
            const bf16* src;
            if (!MLA) src = Q0 + (size_t)qrow * 1024 + h * 64 + 16 * ks + 8 * hi;
            else src = (ks < 8) ? Q0 + (size_t)qrow * 1024 + h * 128 + 16 * ks + 8 * hi : Q1 + (size_t)qrow * 512 + h * 64 + 16 * (ks - 8) + 8 * hi;
            qf[ks] = *(const bf16x8*)src;
        }
        if (!MLA) { __syncthreads(); for (int i = tid; i < 257; i += NTHREADS) Bt[i] = rel_table[h * 257 + i] * 1.4426950408889634f; }
        f32x16 o[NDB];
#pragma unroll
        for (int db = 0; db < NDB; ++db)
#pragma unroll
            for (int r = 0; r < 16; ++r) o[db][r] = 0.f;
        float mrun = -1e30f, lrun = 0.f;
        u32x4 kreg[NKC], vreg[NVC];
        auto prefetch = [&](int kc) {
            const int t0 = tok0 + 64 * kc;
#pragma unroll
            for (int j = 0; j < NKC; ++j) { const int c = tid + NTHREADS * j, row = c / KCH, ch = c % KCH; const bf16* src;
                if (!MLA) src = K0 + (size_t)(t0 + row) * 1024 + h * 64 + ch * 8;
                else src = (ch < 16) ? K0 + (size_t)(t0 + row) * 1024 + h * 128 + ch * 8 : K1 + (size_t)(t0 + row) * 64 + (ch - 16) * 8;
                kreg[j] = *(const u32x4*)src; }
#pragma unroll
            for (int j = 0; j < NVC; ++j) { const int c = tid + NTHREADS * j, kv = c / (DV / 8), dch = c % (DV / 8);
                vreg[j] = *(const u32x4*)(V + (size_t)(t0 + kv) * 1024 + h * DV + dch * 8); }
        };
        prefetch(kc_lo);
        for (int kc = kc_lo; kc <= kc_hi; ++kc) {
            __syncthreads();
#pragma unroll
            for (int j = 0; j < NKC; ++j) { const int c = tid + NTHREADS * j, row = c / KCH, ch = c % KCH; *(LAS u32x4*)(Ks + row * KROW + ch * 8) = kreg[j]; }
#pragma unroll
            for (int j = 0; j < NVC; ++j) { const int c = tid + NTHREADS * j, kv = c / (DV / 8), dch = c % (DV / 8); *(LAS u32x4*)(Vt + kv * VROW + dch * 8) = vreg[j]; }
            __syncthreads();
            if (kc < kc_hi) prefetch(kc + 1);
            const bool active = MLA ? (kc <= cq) : (kc <= cq && kc >= cq - 8);
            if (active) {
                f32x16 st[2];
#pragma unroll
                for (int p = 0; p < 2; ++p)
#pragma unroll
                    for (int r = 0; r < 16; ++r) st[p][r] = 0.f;
                {
                    constexpr int NF = 2 * NKS, KLA = MLA ? 4 : 6;
                    bf16x8 kf[NF];
#define KREAD(f) kf[f] = *(const LAS bf16x8*)(Ks + (32 * ((f) & 1) + pi) * KROW + 16 * ((f) >> 1) + 8 * hi)
#pragma unroll
                    for (int f = 0; f < KLA; ++f) KREAD(f);
                    __builtin_amdgcn_sched_barrier(0);
#pragma unroll
                    for (int g = 0; g < NKS; ++g) {
                        st[0] = __builtin_amdgcn_mfma_f32_32x32x16_bf16(kf[2 * g], qf[g], st[0], 0, 0, 0);
                        st[1] = __builtin_amdgcn_mfma_f32_32x32x16_bf16(kf[2 * g + 1], qf[g], st[1], 0, 0, 0);
                        if (2 * g + KLA < NF) KREAD(2 * g + KLA);
                        if (2 * g + KLA + 1 < NF) KREAD(2 * g + KLA + 1);
                        __builtin_amdgcn_sched_barrier(0);
                    }
#undef KREAD
                }
                if (!MLA) {
                    if (cq - kc >= 3) {
                        const float cbias = Bt[256];
#pragma unroll
                        for (int p = 0; p < 2; ++p)
#pragma unroll
                            for (int r = 0; r < 16; ++r) st[p][r] += cbias;
                    } else {
                        const int base = 64 * (cq - kc) + 32 * (wid & 1) + r32 - 8 * hi + 128;
#pragma unroll
                        for (int p = 0; p < 2; ++p)
#pragma unroll
                            for (int r = 0; r < 16; ++r) { int idx = base - (32 * p + 16 * (r >> 3) + (r & 7)); idx = idx > 256 ? 256 : idx; st[p][r] += Bt[idx]; }
                    }
                }
                float mx = st[0][0];
#pragma unroll
                for (int p = 0; p < 2; ++p)
#pragma unroll
                    for (int r = 0; r < 16; ++r) mx = fmaxf(mx, st[p][r]);
                mx = fmaxf(mx, __shfl_xor(mx, 32));
                const float mnew = fmaxf(mrun, mx), alpha = __builtin_amdgcn_exp2f(mrun - mnew);
                mrun = mnew;
                float rsum = 0.f;
#pragma unroll
                for (int p = 0; p < 2; ++p)
#pragma unroll
                    for (int r = 0; r < 16; ++r) { st[p][r] = __builtin_amdgcn_exp2f(st[p][r] - mnew); rsum += st[p][r]; }
                lrun = lrun * alpha + rsum;
                if (__any(alpha != 1.0f)) {
#pragma unroll
                for (int db = 0; db < NDB; ++db)
#pragma unroll
                    for (int r = 0; r < 16; ++r) o[db][r] *= alpha;
                }
                bf16x8 pf[2][2];
#pragma unroll
                for (int p = 0; p < 2; ++p)
#pragma unroll
                    for (int s = 0; s < 2; ++s) { u32x4 w; w.x = pg8::cvt_pk_bf16(st[p][8 * s + 0], st[p][8 * s + 1]); w.y = pg8::cvt_pk_bf16(st[p][8 * s + 2], st[p][8 * s + 3]);
                        w.z = pg8::cvt_pk_bf16(st[p][8 * s + 4], st[p][8 * s + 5]); w.w = pg8::cvt_pk_bf16(st[p][8 * s + 6], st[p][8 * s + 7]); pf[p][s] = __builtin_bit_cast(bf16x8, w); }
                {
                    constexpr int NFV = 4 * NDB, VLA = MLA ? 2 : 4;
                    bf16x8 vf[NFV];
                    const LAS bf16* vbase = Vt + (8 * hi + ((lane & 15) >> 2)) * VROW + 16 * ((lane >> 4) & 1) + 4 * (lane & 3);
#define VREAD(f) do { const LAS bf16* vp_ = vbase + (32 * (((f) / NDB) >> 1) + 16 * (((f) / NDB) & 1)) * VROW + 32 * ((f) % NDB); \
                        const s16x4 vlo_ = __builtin_bit_cast(s16x4, __builtin_amdgcn_ds_read_tr16_b64_v4i16((LAS s16x4*)vp_)); \
                        const s16x4 vhi_ = __builtin_bit_cast(s16x4, __builtin_amdgcn_ds_read_tr16_b64_v4i16((LAS s16x4*)(vp_ + 4 * VROW))); \
                        vf[f] = __builtin_shufflevector(vlo_, vhi_, 0, 1, 2, 3, 4, 5, 6, 7); } while (0)
#pragma unroll
                    for (int f = 0; f < VLA; ++f) VREAD(f);
                    __builtin_amdgcn_sched_barrier(0);
#pragma unroll
                    for (int f = 0; f < NFV; ++f) {
                        o[f % NDB] = __builtin_amdgcn_mfma_f32_32x32x16_bf16(vf[f], pf[(f / NDB) >> 1][(f / NDB) & 1], o[f % NDB], 0, 0, 0);
                        if (f + VLA < NFV) VREAD(f + VLA);
                        __builtin_amdgcn_sched_barrier(0);
                    }
#undef VREAD
                }
            }
        }
        const float ltot = lrun + __shfl_xor(lrun, 32), rl = 1.0f / ltot;
        bf16* orow = O + (size_t)qrow * 1024 + h * DV;
#pragma unroll
        for (int db = 0; db < NDB; ++db)
#pragma unroll
            for (int j = 0; j < 2; ++j) {
                const unsigned ax = pg8::cvt_pk_bf16(o[db][8 * j] * rl, o[db][8 * j + 1] * rl), ay = pg8::cvt_pk_bf16(o[db][8 * j + 2] * rl, o[db][8 * j + 3] * rl);
                const unsigned bx = pg8::cvt_pk_bf16(o[db][8 * j + 4] * rl, o[db][8 * j + 5] * rl), by = pg8::cvt_pk_bf16(o[db][8 * j + 6] * rl, o[db][8 * j + 7] * rl);
                const auto sx = __builtin_amdgcn_permlane32_swap(ax, bx, false, false); const auto sy = __builtin_amdgcn_permlane32_swap(ay, by, false, false);
                u32x4 w; w.x = sx[0]; w.y = sy[0]; w.z = sx[1]; w.w = sy[1];
                *(u32x4*)(orow + 32 * db + 16 * j + 8 * hi) = w; }
        __syncthreads();
        if (CONV) { const int ucnt = (L - cwg) / G; convert_weights<1>(lane, (int)blockIdx.x * NWAVES + wid, G * NWAVES, ucnt, ucnt + 1); }
    }
    if (CONV) { const int udone = (nunits - cwg + G - 1) / G; convert_weights<1>(lane, (int)blockIdx.x * NWAVES + wid, G * NWAVES, udone > 0 ? udone : 0); }
}

#define RLX_AGENT __ATOMIC_RELAXED, __HIP_MEMORY_SCOPE_AGENT
#define XB_TMO      128
#define XB_XCNT(j)  (256  + 64 * (j))
#define XB_XSUB(j)  (1280 + 64 * (j))
#define XB_XGEN(j)  (2304 + 64 * (j))
#define XB_TOP      3328
#define XB_TOPGEN   3392
#define XCD_BAR_WORDS 3456
#define XB_SPIN_CAP (1u << 18)

__device__ __forceinline__ unsigned xb_ld(unsigned* p)              { return __hip_atomic_load(p, __ATOMIC_RELAXED, __HIP_MEMORY_SCOPE_AGENT); }
__device__ __forceinline__ unsigned xb_add(unsigned* p, unsigned v) { return __hip_atomic_fetch_add(p, v, __ATOMIC_RELAXED, __HIP_MEMORY_SCOPE_AGENT); }
__device__ __forceinline__ unsigned xb_xcc_id() { return (unsigned)__builtin_amdgcn_s_getreg((3 << 11) | 20) & 0xFu; }
#define XB_SPIN(cond, bar) do { unsigned _sp = 0; while (cond) { __builtin_amdgcn_s_sleep(1); \
    if ((++_sp & 255u) == 0u) { if (xb_ld(&(bar)[XB_TMO])) break; if (_sp > XB_SPIN_CAP) { atomicAdd(&(bar)[XB_TMO], 1u); break; } } } } while (0)

struct XcdBarrier {
    unsigned* bar; unsigned x;
    volatile LAS unsigned* st;
};

__device__ __forceinline__ XcdBarrier xcd_barrier_post(unsigned* bar, volatile LAS unsigned* st) {
    XcdBarrier b; b.bar = bar; b.x = xb_xcc_id(); b.st = st;
    if (threadIdx.x == 0) (void)xb_add(&bar[XB_XCNT(b.x)], 1u);
    return b;
}
__device__ __forceinline__ void xcd_barrier_complete(unsigned* bar, unsigned x, unsigned& nloc, unsigned& nx) {
    const unsigned G = gridDim.x * gridDim.y * gridDim.z;
    unsigned sum, cnt, mine, sp = 0u;
    for (;;) {
        sum = 0u; cnt = 0u; mine = 0u;
#pragma unroll
        for (unsigned j = 0; j < 16; ++j) { const unsigned c = xb_ld(&bar[XB_XCNT(j)]); sum += c; cnt += (c > 0u) ? 1u : 0u; mine = (j == x) ? c : mine; }
        if (sum == G) break;
        __builtin_amdgcn_s_sleep(1);
        if ((++sp & 255u) == 0u) { if (xb_ld(&bar[XB_TMO])) break; if (sp > XB_SPIN_CAP) { atomicAdd(&bar[XB_TMO], 1u); break; } }
    }
    nloc = mine > 0u ? mine : 1u; nx = cnt > 0u ? cnt : 1u;
}

__device__ __forceinline__ void xcd_barrier(const XcdBarrier& b) {
    asm volatile("s_waitcnt vmcnt(0)" ::: "memory");
    __syncthreads();
    if (threadIdx.x == 0) {
        unsigned* bar = b.bar;
        __builtin_amdgcn_s_waitcnt(0);
        unsigned nloc = b.st[0], nx = b.st[1];
        if (nloc == 0u) { xcd_barrier_complete(bar, b.x, nloc, nx); b.st[0] = nloc; b.st[1] = nx; }
        const unsigned old = xb_add(&bar[XB_XSUB(b.x)], 1u);
        const unsigned gen = old / nloc;
        if (old + 1u == (gen + 1u) * nloc) {
            __builtin_amdgcn_fence(__ATOMIC_RELEASE, "agent");
            asm volatile("s_waitcnt vmcnt(0)" ::: "memory");
            const unsigned og = xb_add(&bar[XB_TOP], 1u);
            const unsigned tg = og / nx;
            if (og + 1u == (tg + 1u) * nx) xb_add(&bar[XB_TOPGEN], 1u);
            else XB_SPIN(xb_ld(&bar[XB_TOPGEN]) == tg, bar);
            __builtin_amdgcn_fence(__ATOMIC_ACQUIRE, "agent");
            xb_add(&bar[XB_XGEN(b.x)], 1u);
            asm volatile("s_waitcnt vmcnt(0)" ::: "memory");
        } else {
            XB_SPIN(xb_ld(&bar[XB_XGEN(b.x)]) == gen, bar);
            __builtin_amdgcn_fence(__ATOMIC_ACQUIRE, "agent");
            asm volatile("s_waitcnt vmcnt(0)" ::: "memory");
        }
    }
    __syncthreads();
}

__device__ __forceinline__ const void* karg_ptr(int i) {
    const __attribute__((address_space(4))) char* kp = (const __attribute__((address_space(4))) char*)__builtin_amdgcn_kernarg_segment_ptr();
    asm volatile("" : "+s"(kp));
    return *(const void* const __attribute__((address_space(4)))*)(kp + 8 * i);
}
#define KARG(i) ((const float*)karg_ptr(i))
#define WSP ((unsigned char*)karg_ptr(21))
#define HRES ((float*)karg_ptr(20))
#define SSQ ((float*)(WSP + WS_SSQ))
#define ROPE ((float*)(WSP + WS_ROPE))
#define WPTR(off) ((bf16*)(WSP + WS_W + (off)))
#define BPTR(off) ((bf16*)(WSP + (off)))
template <int PASS> __device__ __forceinline__ void convert_weights(int lane, int gw, int NGW, int j0, int j1) {
        constexpr int I_FFIN = 16 * 44, I_FFOUT = 44 * 8, I_QKV = 16 * 24, I_WO = 16 * 8, I_KVD = 16 * 4, I_KVU = 4 * 16, I_DQ = 16 * 6, I_UQ = 12 * 12;
        constexpr int NFM = PASS == 0 ? 1 : 3, W0 = PASS == 0 ? 0 : 1;
        constexpr int NITEMS = PASS == 0 ? (I_FFIN + I_FFOUT + I_QKV) : (3 * I_FFIN + 3 * I_FFOUT + 2 * I_WO + I_KVD + I_KVU + I_DQ + I_UQ);
        for (int j = j0; j < j1; ++j) {
            const int it = gw + NGW * j; if (it >= NITEMS) break;
            int r = it;
            if (r < NFM * I_FFIN) { const int w = W0 + r / I_FFIN, layer = w >> 1, which = w & 1; r -= (w - W0) * I_FFIN;
                conv_item<MAP_SWIGLU>((which ? KARG(6) : KARG(2)) + (size_t)layer * 1024 * 5632, 1024, 5632, 5632, WPTR(WO_FFIN0) + (size_t)w * (W_FFIN / 2), (which ? KARG(5) : KARG(1)) + layer * 1024, r, lane); continue; }
            r -= NFM * I_FFIN;
            if (r < NFM * I_FFOUT) { const int w = W0 + r / I_FFOUT, layer = w >> 1, which = w & 1; r -= (w - W0) * I_FFOUT;
                conv_item<MAP_ID>((which ? KARG(7) : KARG(3)) + (size_t)layer * 2816 * 1024, 2816, 1024, 1024, WPTR(WO_FFOUT0) + (size_t)w * (W_FFOUT / 2), nullptr, r, lane); continue; }
            r -= NFM * I_FFOUT;
            if (PASS == 0) {
                conv_item<MAP_ID>(KARG(8), 1024, 3072, 3072, WPTR(WO_QKV), KARG(4), r, lane);
            } else {
                if (r < I_WO) { conv_item<MAP_ID>(KARG(10), 1024, 1024, 1024, WPTR(WO_AWO), nullptr, r, lane); continue; } r -= I_WO;
                if (r < I_WO) { conv_item<MAP_ID>(KARG(18), 1024, 1024, 1024, WPTR(WO_BWO), nullptr, r, lane); continue; } r -= I_WO;
                if (r < I_KVD) { conv_item<MAP_KVDOWN>(KARG(12), 1024, 320, 512, WPTR(WO_KVD), KARG(11), r, lane); continue; } r -= I_KVD;
                if (r < I_KVU) { conv_item<MAP_ID>(KARG(14), 256, 2048, 2048, WPTR(WO_KVU), KARG(13), r, lane); continue; } r -= I_KVU;
                if (r < I_DQ) { conv_item<MAP_ID>(KARG(15), 1024, 768, 768, WPTR(WO_DQ), KARG(4) + 1024, r, lane); continue; } r -= I_DQ;
                conv_item<MAP_UQ>(KARG(17), 768, 1536, 1536, WPTR(WO_UQ), KARG(16), r, lane);
            }
        }
}
__device__ __forceinline__ void prologue_phase(LAS unsigned char* lds, int tid, int lane, int wave, int G, int bx, int gw, int NGW) {
        convert_weights<0>(lane, gw, NGW);
        { const float* x = KARG(0); bf16* hb = BPTR(WS_HB); float* ssq = SSQ; float* rope = ROPE;
        for (int m = gw; m < M; m += NGW) {
            const f32x4* xr = (const f32x4*)(x + (size_t)m * D) + lane; f32x4 v[4]; float s = 0.f;
#pragma unroll
            for (int j = 0; j < 4; ++j) { v[j] = __builtin_nontemporal_load(xr + 64 * j); s += pg8::sq4(v[j]); }
            s = wave_sum(s);
            u32x2* o8 = (u32x2*)(hb + (size_t)m * D) + lane;
#pragma unroll
            for (int j = 0; j < 4; ++j) { u32x2 w; w.x = pk2(v[j][0], v[j][1]); w.y = pk2(v[j][2], v[j][3]); o8[64 * j] = w; }
            if (lane == 0) ssq[m] = s;
        }
        for (int i = bx * NTHREADS + tid; i < 8 * M; i += G * NTHREADS) ssq[M + i] = 0.f;
        for (int i = bx * NTHREADS + tid; i < 2048 * 32; i += G * NTHREADS) { const int pos = i >> 5, j = i & 31;
            const float freq = powf(10000.0f, -(float)j / 32.0f); const float ang = (float)pos * freq; rope[2 * i] = cosf(ang); rope[2 * i + 1] = sinf(ang); }
        }
        __syncthreads();
    }
#ifndef PROBE_PRO
#define PROBE_PRO
#endif
__global__ void __launch_bounds__(NTHREADS, 2) yoco_fwd(Args args) {
    extern __shared__ __attribute__((aligned(16))) unsigned char lds_raw[];
    LAS unsigned char* lds = (LAS unsigned char*)lds_raw;
    cg::grid_group grid = cg::this_grid();
    const int tid = threadIdx.x, lane = tid & 63, wave = __builtin_amdgcn_readfirstlane(tid >> 6);
    const int G = gridDim.x, bx = blockIdx.x;
    for (int u = tid; u < 64; u += NTHREADS) ((LAS unsigned*)(lds + MISC_OFF))[u] = 0u;
    __syncthreads();
    XcdBarrier bar = xcd_barrier_post((unsigned*)((unsigned char*)karg_ptr(21) + WS_CTL), (volatile LAS unsigned*)(lds + MISC_OFF));
    const int gw = bx * NWAVES + wave, NGW = G * NWAVES;
    const int lo = args.ph_lo, hi = args.ph_hi, use_cg = args.use_cg;
#define IN(k) (lo <= (k) && (k) < hi)
#define SEAM(k) do { if (IN(k) && IN((k) + 1)) { if (use_cg) grid.sync(); else xcd_barrier(bar); } } while (0)
    constexpr float C2A = 0.125f * 1.4426950408889634f;
    constexpr float C2B = 0.07216878364870322f * 1.4426950408889634f;

    if (IN(0)) { prologue_phase(lds, tid, lane, wave, G, bx, gw, NGW); PROBE_PRO }
    SEAM(0);
#define GEMM_PHASE(MODE, Aptr, Bptr, NN, KK, EPI) do { pg8::Gemm g_{Aptr, Bptr, M, NN, KK}; pg8::StaticOrder S_; S_.init(M, NN, G, bx); \
        pg8::gemm_phase<pg8::Epi<MODE>, pg8::StaticOrder, true, true>(lds, g_, S_, EPI); } while (0)
#define FFN_IN(kssq, widx) do { pg8::Epi<pg8::EM_SWIGLU> E{SSQ + (size_t)(kssq) * M, i1024, BPTR(WS_ACT), nullptr, nullptr, nullptr, nullptr, nullptr, 1.f, nullptr}; \
        GEMM_PHASE(pg8::EM_SWIGLU, BPTR(WS_HB), WPTR(WO_FFIN0 + (widx) * W_FFIN), 5632, 1024, E); } while (0)
#define FFN_OUT(MODE, HOLD, kssq, widx) do { pg8::Epi<MODE> E{nullptr, 0.f, BPTR(WS_HB), nullptr, nullptr, HOLD, HRES, SSQ + (size_t)(kssq) * M, 0.5f, nullptr}; \
        GEMM_PHASE(MODE, BPTR(WS_ACT), WPTR(WO_FFOUT0 + (widx) * W_FFOUT), 1024, 2816, E); } while (0)
#define WO_PROJ(Aoff, Woff, kssq) do { pg8::Epi<pg8::EM_RES> E{nullptr, 0.f, BPTR(WS_HB), nullptr, nullptr, nullptr, nullptr, SSQ + (size_t)(kssq) * M, 1.0f, nullptr}; \
        GEMM_PHASE(pg8::EM_RES, BPTR(Aoff), WPTR(Woff), 1024, 1024, E); } while (0)
    const float i1024 = 1.0f / 1024.0f;
    if (IN(1)) FFN_IN(0, 0);
    SEAM(1);
    if (IN(2)) FFN_OUT(pg8::EM_RES, nullptr, 1, 0);
    SEAM(2);
    if (IN(3)) { pg8::Epi<pg8::EM_QKV> E{SSQ + 1 * M, i1024, BPTR(WS_Q), nullptr, nullptr, nullptr, nullptr, nullptr, C2A, nullptr}; GEMM_PHASE(pg8::EM_QKV, BPTR(WS_HB), WPTR(WO_QKV), 3072, 1024, E); }
    SEAM(3);
    if (IN(4)) { attn_phase<0, 1>(lds, G, bx, BPTR(WS_Q), nullptr, BPTR(WS_K), nullptr, BPTR(WS_V), BPTR(WS_Q), KARG(9)); }
    SEAM(4);
    if (IN(5)) WO_PROJ(WS_Q, WO_AWO, 2);
    SEAM(5);
    if (IN(6)) FFN_IN(2, 1);
    SEAM(6);
    if (IN(7)) FFN_OUT(pg8::EM_RES, nullptr, 3, 1);
    SEAM(7);
    if (IN(8)) {
        { pg8::Epi<pg8::EM_KVDOWN> E{SSQ + 3 * M, i1024, BPTR(WS_CKV), BPTR(WS_KR), nullptr, nullptr, nullptr, SSQ + 4 * M, 1.f, ROPE}; GEMM_PHASE(pg8::EM_KVDOWN, BPTR(WS_HB), WPTR(WO_KVD), 512, 1024, E); }
        FFN_IN(3, 2);
    }
    SEAM(8);
    if (IN(9)) {
        if (G != 256) { pg8::Epi<pg8::EM_KVUP> E{SSQ + 4 * M, 1.0f / 256.0f, BPTR(WS_KN), BPTR(WS_VB), nullptr, nullptr, nullptr, nullptr, 1.f, nullptr}; GEMM_PHASE(pg8::EM_KVUP, BPTR(WS_CKV), WPTR(WO_KVU), 2048, 256, E); }
        FFN_OUT(pg8::EM_RES, nullptr, 5, 2);
    }
    SEAM(9);
    if (IN(10)) {
        { pg8::Epi<pg8::EM_DQ> E{SSQ + 5 * M, i1024, BPTR(WS_CQ), nullptr, nullptr, nullptr, nullptr, SSQ + 6 * M, 1.f, nullptr}; GEMM_PHASE(pg8::EM_DQ, BPTR(WS_HB), WPTR(WO_DQ), 768, 1024, E); }
        if (G == 256) {
            pg8::Epi<pg8::EM_KVUP> E{SSQ + 4 * M, 1.0f / 256.0f, BPTR(WS_KN), BPTR(WS_VB), nullptr, nullptr, nullptr, nullptr, 1.f, nullptr};
            pg8::Gemm g_{BPTR(WS_CKV), WPTR(WO_KVU), M, 2048, 256}; pg8::KvuOrder S_{bx};
            pg8::gemm_phase<pg8::Epi<pg8::EM_KVUP>, pg8::KvuOrder, true, true>(lds, g_, S_, E);
        }
    }
    SEAM(10);
    if (IN(11)) { pg8::Epi<pg8::EM_UQ> E{SSQ + 6 * M, 1.0f / 768.0f, BPTR(WS_QN), BPTR(WS_QR), nullptr, nullptr, nullptr, nullptr, C2B, ROPE}; GEMM_PHASE(pg8::EM_UQ, BPTR(WS_CQ), WPTR(WO_UQ), 1536, 768, E); }
    SEAM(11);
    if (IN(12)) attn_phase<1>(lds, G, bx, BPTR(WS_QN), BPTR(WS_QR), BPTR(WS_KN), BPTR(WS_KR), BPTR(WS_VB), BPTR(WS_QN), nullptr);
    SEAM(12);
    if (IN(13)) WO_PROJ(WS_QN, WO_BWO, 7);
    SEAM(13);
    if (IN(14)) FFN_IN(7, 3);
    SEAM(14);
    if (IN(15)) FFN_OUT(pg8::EM_RES_F, nullptr, 8, 3);
    SEAM(15);
    if (IN(16)) {
        float* hres = HRES; const float* ssq = SSQ; const float* final_norm = KARG(19);
        for (int m = gw; m < M; m += NGW) {
            const float rs = __builtin_amdgcn_rsqf(ssq[8 * M + m] * i1024 + pg8::RMS_EPS);
            f32x4* xr = (f32x4*)(hres + (size_t)m * D) + lane; const f32x4* gr = (const f32x4*)final_norm + lane;
#pragma unroll
            for (int j = 0; j < 4; ++j) { const f32x4 v = xr[64 * j], g = gr[64 * j]; __builtin_nontemporal_store(v * rs * g, xr + 64 * j); }
        }
    }
#undef IN
#undef SEAM
}

#ifndef MK_MULTI
#define MK_MULTI 0
#endif
extern "C" void kernel_launch(void* const* d_in, const int* in_sizes, int n_in, void* d_out, int out_size, void* d_ws, size_t ws_size, hipStream_t stream) {
    static int grid = 0;
    if (grid == 0) {
        int dev = 0, cus = 0, per_cu = 0;
        hipGetDevice(&dev);
        hipDeviceGetAttribute(&cus, hipDeviceAttributeMultiprocessorCount, dev);
        hipFuncSetAttribute((const void*)yoco_fwd, hipFuncAttributeMaxDynamicSharedMemorySize, LDS_BYTES);
        hipOccupancyMaxActiveBlocksPerMultiprocessor(&per_cu, (const void*)yoco_fwd, NTHREADS, LDS_BYTES);
        if (per_cu < 1) per_cu = 1;
        grid = cus * 1;
        if (n_in != 20 || ws_size < WS_END) { fprintf(stderr, "kernel_launch: unexpected n_in %d / ws_size %zu (need %zu)\n", n_in, ws_size, (size_t)WS_END); }
        (void)hipGetLastError();
    }
    (void)hipMemsetAsync((char*)d_ws + WS_CTL, 0, CTL_BYTES, stream);
    Args a{};
    for (int i = 0; i < 20; ++i) a.in[i] = (const float*)d_in[i];
    a.out = (float*)d_out; a.ws = (unsigned char*)d_ws;
#if MK_MULTI
    for (int p = 0; p < 17; ++p) { a.ph_lo = p; a.ph_hi = p + 1; void* kargs[] = {&a};
        hipLaunchCooperativeKernel((const void*)yoco_fwd, dim3(grid), dim3(NTHREADS), kargs, LDS_BYTES, stream); }
#else
    a.ph_lo = 0; a.ph_hi = 17; void* kargs[] = {&a};
    hipError_t e = hipLaunchCooperativeKernel((const void*)yoco_fwd, dim3(grid), dim3(NTHREADS), kargs, LDS_BYTES, stream);
    if (e != hipSuccess) fprintf(stderr, "cooperative launch failed: %s (grid %d)\n", hipGetErrorString(e), grid);
#endif
}
```
